# Optimizing an MI355X kernel written in HIP

```python
import math
import jax, jax.numpy as jnp
from jax import lax
import numpy as np

D_MODEL = 1024
BATCH = 2
SEQ = 8192
DEPTH = 1

HEAD_DIM = 64
N_Q_HEADS = 8
N_KV_HEADS = 2
GROUP = N_Q_HEADS // N_KV_HEADS
ATTN_WIDTH = N_Q_HEADS * HEAD_DIM
KV_WIDTH = N_KV_HEADS * HEAD_DIM
WINDOW = 128
BLOCK = 128
ROT_DIM = HEAD_DIM // 4
ROPE_THETA = 500000.0
CONV_WIDTH = D_MODEL - ATTN_WIDTH
CONV_K = 3
PROJ_WIDTH = ATTN_WIDTH + 2 * KV_WIDTH + 3 * CONV_WIDTH
MIX_WIDTH = ATTN_WIDTH + CONV_WIDTH
N_KEYS = 128
N_EXPERTS = N_KEYS * N_KEYS
PEER_HEADS = 8
PEER_QDIM = 256
PEER_HALF = PEER_QDIM // 2
PEER_TOPK = 16
PEER_CHUNK = 128
DN_ALPHA = (2.0 * DEPTH) ** 0.25
DN_BETA = (8.0 * DEPTH) ** -0.25
LN_EPS = 1e-5

kernel_name = "hymba_swa_sink_shortconv_peer_deepnorm"


def layer_norm(x, g, b):
    xf = x.astype(jnp.float32)
    mu = jnp.mean(xf, axis=-1, keepdims=True)
    xc = xf - mu
    var = jnp.mean(xc * xc, axis=-1, keepdims=True)
    return (xc * lax.rsqrt(var + LN_EPS) * g + b).astype(x.dtype)


def rope_tables(positions, dtype):
    inv_freq = ROPE_THETA ** (-jnp.arange(0, ROT_DIM, 2, dtype=jnp.float32) / ROT_DIM)
    ang = positions.astype(jnp.float32)[..., None] * inv_freq
    return jnp.cos(ang)[:, :, None, :].astype(dtype), jnp.sin(ang)[:, :, None, :].astype(dtype)


def partial_rope(t, cos, sin):
    r1 = t[..., :ROT_DIM // 2]
    r2 = t[..., ROT_DIM // 2:ROT_DIM]
    return jnp.concatenate([r1 * cos - r2 * sin, r2 * cos + r1 * sin, t[..., ROT_DIM:]], axis=-1)


def sliding_window_attention_sinks(q, k, v, sinks):
    B, S = q.shape[0], q.shape[1]
    nb = S // BLOCK
    qb = q.reshape(B, nb, BLOCK, N_KV_HEADS, GROUP, HEAD_DIM)
    pad = ((0, 0), (BLOCK, 0), (0, 0), (0, 0))
    kp = jnp.pad(k, pad).reshape(B, nb + 1, BLOCK, N_KV_HEADS, HEAD_DIM)
    vp = jnp.pad(v, pad).reshape(B, nb + 1, BLOCK, N_KV_HEADS, HEAD_DIM)
    kc = jnp.concatenate([kp[:, :-1], kp[:, 1:]], axis=2)
    vc = jnp.concatenate([vp[:, :-1], vp[:, 1:]], axis=2)
    s = jnp.einsum('bnqhgd,bnkhd->bnhgqk', qb, kc).astype(jnp.float32) * (HEAD_DIM ** -0.5)
    qi = jnp.arange(BLOCK)[:, None]
    kj = jnp.arange(2 * BLOCK)[None, :]
    diff = qi + BLOCK - kj
    band = (diff >= 0) & (diff < WINDOW)
    key_abs = jnp.arange(nb)[:, None, None] * BLOCK + kj[None] - BLOCK
    mask = band[None] & (key_abs >= 0)
    s = jnp.where(mask[None, :, None, None], s, -jnp.inf)
    sink = sinks.astype(jnp.float32).reshape(N_KV_HEADS, GROUP)[None, None, :, :, None, None]
    m = jnp.maximum(jnp.max(s, axis=-1, keepdims=True), sink)
    p = jnp.exp(s - m)
    p = p / (jnp.sum(p, axis=-1, keepdims=True) + jnp.exp(sink - m))
    o = jnp.einsum('bnhgqk,bnkhd->bnqhgd', p.astype(v.dtype), vc)
    return o.reshape(B, S, ATTN_WIDTH)


def causal_depthwise_conv3(u, w):
    up = jnp.pad(u, ((0, 0), (CONV_K - 1, 0), (0, 0)))
    return up[:, :-2] * w[0] + up[:, 1:-1] * w[1] + up[:, 2:] * w[2]


def hybrid_mixer(h, cos, sin, w_in, b_in, attn_sinks, conv_w, w_out, b_out):
    B, S, _ = h.shape
    proj = h @ w_in + b_in
    o1 = ATTN_WIDTH
    o2 = o1 + KV_WIDTH
    o3 = o2 + KV_WIDTH
    o4 = o3 + CONV_WIDTH
    o5 = o4 + CONV_WIDTH
    q = proj[..., :o1].reshape(B, S, N_Q_HEADS, HEAD_DIM)
    k = proj[..., o1:o2].reshape(B, S, N_KV_HEADS, HEAD_DIM)
    v = proj[..., o2:o3].reshape(B, S, N_KV_HEADS, HEAD_DIM)
    gate_b = proj[..., o3:o4]
    gate_c = proj[..., o4:o5]
    xc = proj[..., o5:]
    q = partial_rope(q, cos, sin)
    k = partial_rope(k, cos, sin)
    y_attn = sliding_window_attention_sinks(q, k, v, attn_sinks)
    y_conv = gate_b * causal_depthwise_conv3(gate_c * xc, conv_w)
    y = jnp.concatenate([y_attn, y_conv], axis=-1)
    return y @ w_out + b_out


def peer_ffn(h, w_pq, sub_keys1, sub_keys2, u_experts, v_experts):
    B, S, D = h.shape
    T = B * S
    xt = h.reshape(T, D)
    q = (xt @ w_pq).reshape(T, PEER_HEADS, PEER_QDIM)
    s1 = jnp.einsum('thd,nd->thn', q[..., :PEER_HALF], sub_keys1)
    s2 = jnp.einsum('thd,nd->thn', q[..., PEER_HALF:], sub_keys2)
    v1, i1 = lax.top_k(s1, PEER_TOPK)
    v2, i2 = lax.top_k(s2, PEER_TOPK)
    cand = (v1[..., :, None] + v2[..., None, :]).reshape(T, PEER_HEADS, PEER_TOPK * PEER_TOPK)
    sc, pos = lax.top_k(cand, PEER_TOPK)
    e = (jnp.take_along_axis(i1, pos // PEER_TOPK, axis=-1) * N_KEYS
         + jnp.take_along_axis(i2, pos % PEER_TOPK, axis=-1))
    g = jax.nn.softmax(sc.astype(jnp.float32), axis=-1).astype(h.dtype)
    nc = T // PEER_CHUNK
    kk = PEER_HEADS * PEER_TOPK
    xs = xt.reshape(nc, PEER_CHUNK, D)
    es = e.reshape(nc, PEER_CHUNK, kk)
    gs = g.reshape(nc, PEER_CHUNK, kk)

    def chunk(args):
        xc, ec, gc = args
        u = jnp.take(u_experts, ec, axis=0)
        a = jax.nn.gelu(jnp.einsum('tkd,td->tk', u, xc), approximate=False)
        vv = jnp.take(v_experts, ec, axis=0)
        return jnp.einsum('tk,tkd->td', gc * a, vv)

    out = lax.map(chunk, (xs, es, gs))
    return out.reshape(B, S, D)


def setup_inputs(seed: int = 0) -> dict:
    key = jax.random.key(seed)
    ks = jax.random.split(key, 20)
    f32 = jnp.float32
    nrm = lambda k, shape, scale: jax.random.normal(k, shape, f32) * scale
    x = jax.random.normal(ks[0], (BATCH, SEQ, D_MODEL), f32)
    offs = jax.random.randint(ks[1], (BATCH, 1), 0, 1024, dtype=jnp.int32)
    positions = (jnp.arange(SEQ, dtype=jnp.int32)[None, :] + offs).astype(jnp.int32)
    return {
        "x": x,
        "positions": positions,
        "w_in": nrm(ks[2], (DEPTH, D_MODEL, PROJ_WIDTH), D_MODEL ** -0.5),
        "b_in": nrm(ks[3], (DEPTH, PROJ_WIDTH), 0.02),
        "attn_sinks": nrm(ks[4], (DEPTH, N_Q_HEADS), 0.5),
        "conv_w": nrm(ks[5], (DEPTH, CONV_K, CONV_WIDTH), CONV_K ** -0.5),
        "w_out": nrm(ks[6], (DEPTH, MIX_WIDTH, D_MODEL), MIX_WIDTH ** -0.5 * DN_BETA),
        "b_out": nrm(ks[7], (DEPTH, D_MODEL), 0.02),
        "ln1_g": 1.0 + nrm(ks[8], (DEPTH, D_MODEL), 0.02),
        "ln1_b": nrm(ks[9], (DEPTH, D_MODEL), 0.02),
        "w_pq": nrm(ks[10], (DEPTH, D_MODEL, PEER_HEADS * PEER_QDIM), D_MODEL ** -0.5),
        "sub_keys1": nrm(ks[11], (DEPTH, N_KEYS, PEER_HALF), PEER_HALF ** -0.5),
        "sub_keys2": nrm(ks[12], (DEPTH, N_KEYS, PEER_HALF), PEER_HALF ** -0.5),
        "u_experts": nrm(ks[13], (DEPTH, N_EXPERTS, D_MODEL), D_MODEL ** -0.5),
        "v_experts": nrm(ks[14], (DEPTH, N_EXPERTS, D_MODEL), (PEER_HEADS * PEER_TOPK) ** -0.5 * DN_BETA),
        "ln2_g": 1.0 + nrm(ks[15], (DEPTH, D_MODEL), 0.02),
        "ln2_b": nrm(ks[16], (DEPTH, D_MODEL), 0.02),
    }


def reference(x, positions, w_in, b_in, attn_sinks, conv_w, w_out, b_out, ln1_g, ln1_b,
              w_pq, sub_keys1, sub_keys2, u_experts, v_experts, ln2_g, ln2_b):
    cos, sin = rope_tables(positions, x.dtype)
    h = x
    for l in range(DEPTH):
        mix = hybrid_mixer(h, cos, sin, w_in[l], b_in[l], attn_sinks[l], conv_w[l], w_out[l], b_out[l])
        h = layer_norm(DN_ALPHA * h + mix, ln1_g[l], ln1_b[l])
        ff = peer_ffn(h, w_pq[l], sub_keys1[l], sub_keys2[l], u_experts[l], v_experts[l])
        h = layer_norm(DN_ALPHA * h + ff, ln2_g[l], ln2_b[l])
    return h
```

```cpp
#include <hip/hip_runtime.h>
#include <cstdio>
#include <cstdint>
namespace pg8 {
#define PG8_LAS __attribute__((address_space(3)))
typedef unsigned short bf16_t;
typedef short bf16x8 __attribute__((ext_vector_type(8)));
typedef float f32x4 __attribute__((ext_vector_type(4)));
typedef unsigned u32x4 __attribute__((ext_vector_type(4)));
constexpr int BM = 256, BK = 64, HALF = 128, HTB = HALF * BK * 2  , STAGE_BYTES = 8 * HTB, NXCD = 8, WGM = 8;

__host__ __device__ __forceinline__ int lds_byte(int r, int c) { const int st = (r >> 4) * 2 + (c >> 5), rr = r & 15, cc = c & 31, ob = rr * 64 + cc * 2; return st * 1024 + (ob ^ (((ob >> 9) & 1) << 5)); }
__host__ __device__ __forceinline__ void stage_rc(int b, int& R, int& C) { const int st = b / 1024, sb = b % 1024, swz = sb ^ (((sb >> 9) & 1) << 5); R = (st >> 1) * 16 + swz / 64; C = (st & 1) * 32 + (swz % 64) / 2; }
__host__ __device__ __forceinline__ int perm32(int rho) { const int n = rho >> 4, i = rho & 15; return 8 * (i >> 2) + 4 * n + (i & 3); }

struct Unit { int pm, pn; };
struct Gemm { const bf16_t* A; const bf16_t* Bt; int M, N, K; };

struct StaticOrder {
    int nM, nN, nwg, G, c;
    __host__ __device__ void init(int M, int N, int G_, int c_) { nM = M / BM; nN = N / BM; nwg = nM * nN; G = G_; c = c_; }
    __host__ __device__ bool next(int i, Unit& u) const {
        const long L = (long)i * G + c; if (L >= nwg) return false;
        int wgid = (int)L; { const int q = nwg / NXCD, r = nwg % NXCD, xcd = wgid % NXCD, off = wgid / NXCD; wgid = (xcd < r ? xcd * (q + 1) : r * (q + 1) + (xcd - r) * q) + off; }
        const int nig = WGM * nN, gid = wgid / nig, fm = gid * WGM, gsz = (nM - fm) < WGM ? (nM - fm) : WGM;
        u.pm = fm + ((wgid % nig) % gsz); u.pn = (wgid % nig) / gsz; return true;
    }
    __device__ __forceinline__ void a_ready(const Unit&) const {}
    __device__ __forceinline__ void done(const Unit&) const {}
};

__device__ __forceinline__ unsigned cvt_pk_bf16(float lo, float hi) { unsigned r; asm volatile("v_cvt_pk_bf16_f32 %0, %1, %2" : "=v"(r) : "v"(lo), "v"(hi)); return r; }
typedef float f32x2 __attribute__((ext_vector_type(2)));
__device__ __forceinline__ f32x2 gelu_pk(f32x2 v) {
    const f32x2 av = __builtin_elementwise_abs(v), d = av * 0.2316418882f + 1.0f;
    f32x2 t; t.x = __builtin_amdgcn_rcpf(d.x); t.y = __builtin_amdgcn_rcpf(d.y);
    f32x2 q = t * 0.5307027145f + (-0.7265760135f); q = q * t + 0.7107068705f; q = q * t + (-0.142248368f); q = q * t + 0.127414796f; q = q * t;
    const f32x2 s = (v * v) * (-0.72134752044f);
    f32x2 e; e.x = __builtin_amdgcn_exp2f(s.x); e.y = __builtin_amdgcn_exp2f(s.y);
    const f32x2 m = v * (q * e), r = v - m;
    f32x2 o; o.x = v.x < 0.f ? m.x : r.x; o.y = v.y < 0.f ? m.y : r.y; return o;
}

template <int ACT  > struct EpiBf16 {
    static constexpr bool PERM = true, AFTER_DRAIN = false; static_assert(ACT == 0 || ACT == 1, "EpiBf16: ACT is 0 (none) or 1 (gelu_pk)");
    bf16_t* O; int ldc; const float* bias; int split_cols; size_t split_stride; float scale0;
    __device__ __forceinline__ void operator()(const f32x4 (&acc)[2][2][4][2], const Unit& u, int wr, int wc, int fr, int fq) const {
        const int row0 = u.pm * BM + wr * 64 + fr; int colt = u.pn * BM; bf16_t* base = O;
        float sc = 1.f; if (split_cols) { const int t = colt / split_cols; base += (size_t)t * split_stride; colt -= t * split_cols; if (t == 0) sc = scale0; }
        const int col0 = colt + wc * 32 + 8 * fq, bcol0 = u.pn * BM + wc * 32 + 8 * fq;
        f32x4 bv[2][2];
#pragma unroll
        for (int bj = 0; bj < 2; ++bj)
#pragma unroll
            for (int n = 0; n < 2; ++n) bv[bj][n] = bias ? *(const f32x4*)(bias + bcol0 + bj * HALF + 4 * n) : (f32x4){0.f, 0.f, 0.f, 0.f};
#pragma unroll
        for (int ai = 0; ai < 2; ++ai)
#pragma unroll
            for (int m = 0; m < 4; ++m) { bf16_t* rowp = base + (size_t)(row0 + ai * HALF + m * 16) * ldc + col0;
#pragma unroll
                for (int bj = 0; bj < 2; ++bj) { f32x4 v0 = acc[ai][bj][m][0] + bv[bj][0], v1 = acc[ai][bj][m][1] + bv[bj][1];
                    if (ACT == 1) { f32x2 a = gelu_pk((f32x2){v0[0], v0[1]}), b = gelu_pk((f32x2){v0[2], v0[3]}), c = gelu_pk((f32x2){v1[0], v1[1]}), d = gelu_pk((f32x2){v1[2], v1[3]});
                        v0 = (f32x4){a.x, a.y, b.x, b.y}; v1 = (f32x4){c.x, c.y, d.x, d.y}; }
                    v0 = v0 * sc; v1 = v1 * sc; u32x4 w; w.x = cvt_pk_bf16(v0[0], v0[1]); w.y = cvt_pk_bf16(v0[2], v0[3]); w.z = cvt_pk_bf16(v1[0], v1[1]); w.w = cvt_pk_bf16(v1[2], v1[3]);
                    *(u32x4*)(rowp + bj * HALF) = w; } }
    }
};

struct PanelStats {
    unsigned* xbuf;
    unsigned* cnt;
    unsigned* tmo;
    int ntn; float eps;
    unsigned code;
    __device__ __forceinline__ bool run(const f32x4 (&v)[2][2][4][2], const Unit& u, int wr, int wc, int fr, int fq, PG8_LAS unsigned char* lds, int wid, int lane) const {
        typedef float f32x2v __attribute__((ext_vector_type(2)));
        PG8_LAS f32x2v* P = (PG8_LAS f32x2v*)lds;
        PG8_LAS f32x2v* S = (PG8_LAS f32x2v*)(lds + 8192);
        PG8_LAS unsigned* flag = (PG8_LAS unsigned*)(lds + 8192 + 2048);
#pragma unroll
        for (int ai = 0; ai < 2; ++ai)
#pragma unroll
            for (int m = 0; m < 4; ++m) {
                float s = 0.f;
#pragma unroll
                for (int bj = 0; bj < 2; ++bj)
#pragma unroll
                    for (int n = 0; n < 2; ++n) { const f32x4 x = v[ai][bj][m][n]; s += (x[0] + x[1]) + (x[2] + x[3]); }
                s += __shfl_xor(s, 16); s += __shfl_xor(s, 32);
                const float mw = s * (1.0f / 64.0f); float q = 0.f;
#pragma unroll
                for (int bj = 0; bj < 2; ++bj)
#pragma unroll
                    for (int n = 0; n < 2; ++n) { const f32x4 d = v[ai][bj][m][n] - mw; q += (d[0] * d[0] + d[1] * d[1]) + (d[2] * d[2] + d[3] * d[3]); }
                q += __shfl_xor(q, 16); q += __shfl_xor(q, 32);
                if (fq == 0) P[(ai * HALF + wr * 64 + m * 16 + fr) * 4 + wc] = (f32x2v){mw, q};
            }
        asm volatile("s_waitcnt lgkmcnt(0)" ::: "memory"); __builtin_amdgcn_s_barrier(); asm volatile("" ::: "memory");
#if defined(BROKEN_EXCHANGE_NO_WAIT)
#warning BROKEN CONTROL BUILD: the row-statistics exchange does not wait; results are wrong by design
        if (blockIdx.x >= 64) { const long long t0_ = clock64(); while (clock64() - t0_ < 60000) __builtin_amdgcn_s_sleep(8); }
#endif
        const int row = wid * 32 + (lane & 31);
        if (lane < 32) {
            const f32x2v a = P[row * 4 + 0], b = P[row * 4 + 1], c = P[row * 4 + 2], d = P[row * 4 + 3];
            const float mt = (a.x + b.x + c.x + d.x) * 0.25f;
            const float da = a.x - mt, db = b.x - mt, dc = c.x - mt, dd = d.x - mt;
            const float m2 = (a.y + b.y) + (c.y + d.y) + 64.0f * ((da * da + db * db) + (dc * dc + dd * dd));
            unsigned long long* slot = (unsigned long long*)xbuf + ((size_t)(u.pm * BM + row) * 4 + u.pn);
            __hip_atomic_store(slot, ((unsigned long long)__float_as_uint(m2) << 32) | __float_as_uint(mt), __ATOMIC_RELAXED, __HIP_MEMORY_SCOPE_AGENT);
        }
        asm volatile("s_waitcnt vmcnt(0)" ::: "memory");
        if (lane == 0) __hip_atomic_fetch_add(cnt + 64 * u.pm, 1u, __ATOMIC_RELAXED, __HIP_MEMORY_SCOPE_AGENT);
        if (wid == 0) {
            bool dead = false; const unsigned long long t0 = __builtin_amdgcn_s_memrealtime(); const unsigned want = 8u * (unsigned)ntn;
            for (;;) {
#if defined(BROKEN_EXCHANGE_NO_WAIT)
                break;
#endif
                if ((unsigned)__builtin_amdgcn_readfirstlane(__hip_atomic_load(cnt + 64 * u.pm, __ATOMIC_RELAXED, __HIP_MEMORY_SCOPE_AGENT)) >= want) break;
                if (__builtin_amdgcn_s_memrealtime() - t0 > 2000000ull) {
                    if (lane == 0) { unsigned expect = 0u; __hip_atomic_compare_exchange_strong(tmo + 1, &expect, code | (unsigned)(u.pm & 0xff), __ATOMIC_RELAXED, __ATOMIC_RELAXED, __HIP_MEMORY_SCOPE_AGENT);
                                     __hip_atomic_store(tmo, 1u, __ATOMIC_RELAXED, __HIP_MEMORY_SCOPE_AGENT); }
                    dead = true; break; }
                __builtin_amdgcn_s_sleep(2);
            }
            __builtin_amdgcn_fence(__ATOMIC_ACQUIRE, "agent");
            if (lane == 0) flag[0] = dead ? 1u : 0u;
        }
        asm volatile("s_waitcnt vmcnt(0) lgkmcnt(0)" ::: "memory"); __builtin_amdgcn_s_barrier(); asm volatile("" ::: "memory");
        const bool bad = flag[0] != 0u;
        if (lane < 32) {
            const unsigned long long* slot = (const unsigned long long*)xbuf + (size_t)(u.pm * BM + row) * 4; float mt[4], m2[4]; float ms = 0.f;
#pragma unroll
            for (int t = 0; t < 4; ++t) { if (t < ntn) { const unsigned long long w = __hip_atomic_load(slot + t, __ATOMIC_RELAXED, __HIP_MEMORY_SCOPE_AGENT); mt[t] = __uint_as_float((unsigned)w); m2[t] = __uint_as_float((unsigned)(w >> 32)); } else { mt[t] = 0.f; m2[t] = 0.f; } ms += mt[t]; }
            const float mean = ms / (float)ntn; float q = 0.f;
#pragma unroll
            for (int t = 0; t < 4; ++t) if (t < ntn) { const float dm = mt[t] - mean; q += m2[t] + 256.0f * dm * dm; }
            S[row] = (f32x2v){mean, 1.0f / sqrtf(q / (256.0f * (float)ntn) + eps)};
        }
        asm volatile("s_waitcnt lgkmcnt(0)" ::: "memory"); __builtin_amdgcn_s_barrier(); asm volatile("" ::: "memory");
        return bad;
    }
};
struct EpiLnRes {
    static constexpr bool PERM = false, AFTER_DRAIN = true;
    const float* base; float* out; int ldc; const float* bias; PanelStats st; unsigned poison;
    __device__ __forceinline__ void fused(f32x4 (&acc)[2][2][4][2], const Unit& u, int wr, int wc, int fr, int fq, PG8_LAS unsigned char* lds, int wid, int lane) const {
        typedef float f32x2v __attribute__((ext_vector_type(2)));
        const PG8_LAS f32x2v* S = (const PG8_LAS f32x2v*)(lds + 8192);
        const int col0 = u.pn * BM + wc * 32 + 4 * fq;
#pragma unroll
        for (int bj = 0; bj < 2; ++bj)
#pragma unroll
            for (int n = 0; n < 2; ++n) { const f32x4 bv = bias ? *(const f32x4*)(bias + col0 + bj * HALF + n * 16) : (f32x4){0.f, 0.f, 0.f, 0.f};
#pragma unroll
                for (int ai = 0; ai < 2; ++ai)
#pragma unroll
                    for (int m = 0; m < 4; ++m) acc[ai][bj][m][n] += bv; }
        f32x4 pre[4][2][2];
#pragma unroll
        for (int m = 0; m < 4; ++m) { const size_t off = (size_t)(u.pm * BM + wr * 64 + m * 16 + fr) * ldc + col0;
#pragma unroll
            for (int bj = 0; bj < 2; ++bj)
#pragma unroll
                for (int n = 0; n < 2; ++n) pre[m][bj][n] = *(const f32x4*)(base + off + bj * HALF + n * 16); }
        const bool bad = st.run(acc, u, wr, wc, fr, fq, lds, wid, lane) || poison != 0u;
        const float qnan = __builtin_nanf("");
#pragma unroll
        for (int ai = 0; ai < 2; ++ai)
#pragma unroll
            for (int m = 0; m < 4; ++m) { const int r = ai * HALF + wr * 64 + m * 16 + fr; const f32x2v sr = S[r]; const size_t off = (size_t)(u.pm * BM + r) * ldc + col0;
#pragma unroll
                for (int bj = 0; bj < 2; ++bj)
#pragma unroll
                    for (int n = 0; n < 2; ++n) { const f32x4 bs = ai == 0 ? pre[m][bj][n] : *(const f32x4*)(base + off + bj * HALF + n * 16); f32x4 o = bs + (acc[ai][bj][m][n] - sr.x) * sr.y;
                        if (bad) o = (f32x4){qnan, qnan, qnan, qnan}; *(f32x4*)(out + off + bj * HALF + n * 16) = o; }
                if (m & 1) asm volatile("" ::: "memory"); }
    }
};
struct EpiLnResLn {
    static constexpr bool PERM = false, AFTER_DRAIN = true;
    const float* base; float* out; bf16_t* xn; int ldc; const float* bias; PanelStats st1, st2; unsigned poison;
    __device__ __forceinline__ void fused(f32x4 (&acc)[2][2][4][2], const Unit& u, int wr, int wc, int fr, int fq, PG8_LAS unsigned char* lds, int wid, int lane) const {
        typedef float f32x2v __attribute__((ext_vector_type(2))); typedef unsigned u32x2v __attribute__((ext_vector_type(2)));
        const PG8_LAS f32x2v* S = (const PG8_LAS f32x2v*)(lds + 8192);
        const int col0 = u.pn * BM + wc * 32 + 4 * fq;
#pragma unroll
        for (int bj = 0; bj < 2; ++bj)
#pragma unroll
            for (int n = 0; n < 2; ++n) { const f32x4 bv = bias ? *(const f32x4*)(bias + col0 + bj * HALF + n * 16) : (f32x4){0.f, 0.f, 0.f, 0.f};
#pragma unroll
                for (int ai = 0; ai < 2; ++ai)
#pragma unroll
                    for (int m = 0; m < 4; ++m) acc[ai][bj][m][n] += bv; }
        bool bad = st1.run(acc, u, wr, wc, fr, fq, lds, wid, lane) || poison != 0u;
        const float qnan = __builtin_nanf("");
#pragma unroll
        for (int ai = 0; ai < 2; ++ai)
#pragma unroll
            for (int m = 0; m < 4; ++m) { const int r = ai * HALF + wr * 64 + m * 16 + fr; const f32x2v sr = S[r]; const size_t off = (size_t)(u.pm * BM + r) * ldc + col0;
#pragma unroll
                for (int bj = 0; bj < 2; ++bj)
#pragma unroll
                    for (int n = 0; n < 2; ++n) { const f32x4 bs = *(const f32x4*)(base + off + bj * HALF + n * 16); acc[ai][bj][m][n] = bs + (acc[ai][bj][m][n] - sr.x) * sr.y; }
                asm volatile("" : "+v"(acc[ai][0][m][0]), "+v"(acc[ai][0][m][1]), "+v"(acc[ai][1][m][0]), "+v"(acc[ai][1][m][1]));
                if (m & 1) asm volatile("" ::: "memory"); }
        const bool bad1 = bad;
        bad = st2.run(acc, u, wr, wc, fr, fq, lds, wid, lane) || bad;
#pragma unroll
        for (int ai = 0; ai < 2; ++ai)
#pragma unroll
            for (int m = 0; m < 4; ++m) { const int r = ai * HALF + wr * 64 + m * 16 + fr; const f32x2v sr = S[r]; const size_t off = (size_t)(u.pm * BM + r) * ldc + col0;
#pragma unroll
                for (int bj = 0; bj < 2; ++bj)
#pragma unroll
                    for (int n = 0; n < 2; ++n) { const f32x4 x1 = acc[ai][bj][m][n]; *(f32x4*)(out + off + bj * HALF + n * 16) = bad1 ? (f32x4){qnan, qnan, qnan, qnan} : x1;
                        const f32x4 o = (x1 - sr.x) * sr.y; u32x2v w; w.x = cvt_pk_bf16(o[0], o[1]); w.y = cvt_pk_bf16(o[2], o[3]);
                        if (bad) { w.x = 0x7fc07fc0u; w.y = 0x7fc07fc0u; } *(u32x2v*)(xn + off + bj * HALF + n * 16) = w; }
                asm volatile("" ::: "memory"); }
    }
};

template <class Epi, class Sched, bool ALIGN_EPI = false, bool SP2 = false>
__device__ __forceinline__ void gemm_phase(PG8_LAS unsigned char* lds, const Gemm g, const Sched& S, const Epi& E) {
    const int tid = threadIdx.x, wid = __builtin_amdgcn_readfirstlane(tid >> 6), lane = tid & 63, wr = wid >> 2, wc = wid & 3, fr = lane & 15, fq = lane >> 4;
    const int K = g.K, nt = K / BK;
    unsigned voffA[2], voffB[2];
#pragma unroll
    for (int i = 0; i < 2; ++i) { int R, C; stage_rc(tid * 16 + i * 8192, R, C); const int Rb = Epi::PERM ? ((R & ~31) + perm32(R & 31)) : R;
        voffA[i] = (unsigned)(R * K + C) * 2u; voffB[i] = (unsigned)(Rb * K + C) * 2u; }
    const size_t kstep = (size_t)(BK * 2);
    const size_t hstep = (size_t)HALF * K * 2;
    const size_t tstep = 2 * hstep;
    const unsigned ldsw = (unsigned)wid * 1024u;
    const int aoff = lds_byte(wr * 64 + fr, fq * 8), boff = lds_byte(wc * 32 + fr, fq * 8);
#define PG8_SA(b, h) (((b) * 2 + (h)) * HTB)
#define PG8_SB(b, h) ((4 + (b) * 2 + (h)) * HTB)
#define PG8_STAGE(bufoff, gbase, voff) do { _Pragma("unroll") for (int _i = 0; _i < 2; ++_i) \
        __builtin_amdgcn_global_load_lds((const unsigned*)((const char*)(gbase) + (voff)[_i]), (PG8_LAS unsigned*)(lds + (bufoff) + ldsw + _i * 8192), 16, 0, 0); } while (0)
#define PG8_LDA(dst, b, h) do { _Pragma("unroll") for (int m = 0; m < 4; ++m) _Pragma("unroll") for (int k = 0; k < 2; ++k) dst[m][k] = *(const PG8_LAS bf16x8*)(lds + PG8_SA(b, h) + aoff + m * 2048 + k * 1024); } while (0)
#define PG8_LDB(dst, b, h) do { _Pragma("unroll") for (int n = 0; n < 2; ++n) _Pragma("unroll") for (int k = 0; k < 2; ++k) dst[n][k] = *(const PG8_LAS bf16x8*)(lds + PG8_SB(b, h) + boff + n * 2048 + k * 1024); } while (0)
#define PG8_MMA(ai, bj, At, Bt) do { __builtin_amdgcn_s_setprio(1); _Pragma("unroll") for (int m = 0; m < 4; ++m) _Pragma("unroll") for (int n = 0; n < 2; ++n) _Pragma("unroll") for (int k = 0; k < 2; ++k) \
        acc[ai][bj][m][n] = __builtin_amdgcn_mfma_f32_16x16x32_bf16(Bt[n][k], At[m][k], acc[ai][bj][m][n], 0, 0, 0); __builtin_amdgcn_s_setprio(0); } while (0)
#define PG8_WAIT_V(n) asm volatile("s_waitcnt vmcnt(" #n ")" ::: "memory")
#define PG8_WAIT_L(n) asm volatile("s_waitcnt lgkmcnt(" #n ")" ::: "memory")
#define PG8_BAR __builtin_amdgcn_s_barrier()
#define PG8_SCHED __builtin_amdgcn_sched_barrier(0)
    Unit cur, nxt; int ui = 0;
    if (!S.next(0, cur)) return;
    f32x4 acc[2][2][4][2];
#pragma unroll
    for (int a = 0; a < 2; ++a)
#pragma unroll
        for (int b = 0; b < 2; ++b)
#pragma unroll
            for (int m = 0; m < 4; ++m)
#pragma unroll
                for (int n = 0; n < 2; ++n) acc[a][b][m][n] = (f32x4){0.f, 0.f, 0.f, 0.f};
    bf16x8 At[4][2], B0[2][2], B1[2][2];
    const char* cA = (const char*)g.A + (size_t)cur.pm * tstep; const char* cB = (const char*)g.Bt + (size_t)cur.pn * tstep;
    S.a_ready(cur);
    if constexpr (SP2) {
        PG8_STAGE(PG8_SB(0, 0), cB, voffB); PG8_STAGE(PG8_SB(0, 1), cB + hstep, voffB); PG8_STAGE(PG8_SA(0, 0), cA, voffA); PG8_STAGE(PG8_SA(0, 1), cA + hstep, voffA);
        if (wr == 1) PG8_BAR;
        PG8_WAIT_V(2); PG8_BAR;
        PG8_STAGE(PG8_SB(1, 0), cB + kstep, voffB); PG8_STAGE(PG8_SA(1, 0), cA + kstep, voffA); PG8_STAGE(PG8_SB(1, 1), cB + hstep + kstep, voffB);
        PG8_WAIT_V(6); PG8_BAR;
    } else {
        PG8_STAGE(PG8_SB(0, 0), cB, voffB); PG8_STAGE(PG8_SA(0, 0), cA, voffA); PG8_STAGE(PG8_SB(0, 1), cB + hstep, voffB); PG8_STAGE(PG8_SA(0, 1), cA + hstep, voffA);
        if (wr == 1) PG8_BAR;
        PG8_WAIT_V(4); PG8_BAR;
        PG8_STAGE(PG8_SB(1, 0), cB + kstep, voffB); PG8_STAGE(PG8_SA(1, 0), cA + kstep, voffA); PG8_STAGE(PG8_SB(1, 1), cB + hstep + kstep, voffB);
        PG8_WAIT_V(6); PG8_BAR;
    }
    for (;;) {
        const bool has_next = S.next(ui + 1, nxt);
        const char* nA = has_next ? (const char*)g.A + (size_t)nxt.pm * tstep : cA; const char* nB = has_next ? (const char*)g.Bt + (size_t)nxt.pn * tstep : cB;
        for (int t = 0; t < nt; t += 2) {
            const bool last = (t == nt - 2);
            const char* a1 = cA + (size_t)(t + 1) * kstep;
            const char* a2 = last ? nA : cA + (size_t)(t + 2) * kstep; const char* b2 = last ? nB : cB + (size_t)(t + 2) * kstep;
            const char* a3 = a2 + kstep; const char* b3 = b2 + kstep;
            if (last && has_next) S.a_ready(nxt);
            if constexpr (SP2) {
            PG8_LDB(B0, 0, 0); PG8_LDB(B1, 0, 1); PG8_SCHED; PG8_LDA(At, 0, 0); PG8_STAGE(PG8_SA(1, 1), a1 + hstep, voffA);
            PG8_WAIT_V(8); PG8_WAIT_L(0); PG8_BAR; PG8_MMA(0, 0, At, B0); PG8_MMA(0, 1, At, B1); PG8_BAR; PG8_SCHED;
            PG8_LDA(At, 0, 1); PG8_STAGE(PG8_SB(0, 0), b2, voffB); PG8_STAGE(PG8_SB(0, 1), b2 + hstep, voffB); PG8_STAGE(PG8_SA(0, 0), a2, voffA);
            PG8_WAIT_V(8); PG8_WAIT_L(0); PG8_BAR; PG8_MMA(1, 0, At, B0); PG8_MMA(1, 1, At, B1); PG8_BAR; PG8_SCHED;
            PG8_LDB(B0, 1, 0); PG8_LDB(B1, 1, 1); PG8_SCHED; PG8_LDA(At, 1, 0); PG8_STAGE(PG8_SA(0, 1), a2 + hstep, voffA);
            PG8_WAIT_V(8); PG8_WAIT_L(0); PG8_BAR; PG8_MMA(0, 0, At, B0); PG8_MMA(0, 1, At, B1); PG8_BAR; PG8_SCHED;
            PG8_LDA(At, 1, 1); PG8_STAGE(PG8_SB(1, 0), b3, voffB); PG8_STAGE(PG8_SB(1, 1), b3 + hstep, voffB); PG8_STAGE(PG8_SA(1, 0), a3, voffA);
            PG8_WAIT_V(8); PG8_WAIT_L(0); PG8_BAR; PG8_MMA(1, 0, At, B0); PG8_MMA(1, 1, At, B1); PG8_BAR; PG8_SCHED;
            } else {
            PG8_LDB(B0, 0, 0); PG8_SCHED; PG8_LDA(At, 0, 0); PG8_STAGE(PG8_SA(1, 1), a1 + hstep, voffA);
            PG8_WAIT_L(8); PG8_BAR; PG8_WAIT_L(0); PG8_MMA(0, 0, At, B0); PG8_BAR; PG8_SCHED;
            PG8_LDB(B1, 0, 1); PG8_STAGE(PG8_SB(0, 0), b2, voffB);
            PG8_BAR; PG8_WAIT_L(0); PG8_MMA(0, 1, At, B1); PG8_BAR;
            PG8_LDA(At, 0, 1); PG8_STAGE(PG8_SA(0, 0), a2, voffA);
            PG8_BAR; PG8_WAIT_L(0); PG8_MMA(1, 0, At, B0); PG8_BAR; PG8_SCHED;
            PG8_STAGE(PG8_SB(0, 1), b2 + hstep, voffB);
            PG8_WAIT_V(6); PG8_BAR; PG8_MMA(1, 1, At, B1); PG8_BAR;
            PG8_LDB(B0, 1, 0); PG8_SCHED; PG8_LDA(At, 1, 0); PG8_STAGE(PG8_SA(0, 1), a2 + hstep, voffA);
            PG8_WAIT_L(8); PG8_BAR; PG8_WAIT_L(0); PG8_MMA(0, 0, At, B0); PG8_BAR; PG8_SCHED;
            PG8_LDB(B1, 1, 1); PG8_STAGE(PG8_SB(1, 0), b3, voffB);
            PG8_BAR; PG8_WAIT_L(0); PG8_MMA(0, 1, At, B1); PG8_BAR;
            PG8_LDA(At, 1, 1); PG8_STAGE(PG8_SA(1, 0), a3, voffA);
            PG8_BAR; PG8_WAIT_L(0); PG8_MMA(1, 0, At, B0); PG8_BAR; PG8_SCHED;
            PG8_STAGE(PG8_SB(1, 1), b3 + hstep, voffB);
            PG8_WAIT_V(6); PG8_BAR; PG8_MMA(1, 1, At, B1); PG8_BAR;
            }
        }
        if constexpr (ALIGN_EPI) { if (wr == 0) PG8_BAR; }
        if constexpr (!Epi::AFTER_DRAIN) { E(acc, cur, wr, wc, fr, fq); S.done(cur); }
        if (!has_next) break;
#pragma unroll
        for (int a = 0; a < 2; ++a)
#pragma unroll
            for (int b = 0; b < 2; ++b)
#pragma unroll
                for (int m = 0; m < 4; ++m)
#pragma unroll
                    for (int n = 0; n < 2; ++n) acc[a][b][m][n] = (f32x4){0.f, 0.f, 0.f, 0.f};
        cur = nxt; cA = nA; cB = nB; ++ui;
        if constexpr (ALIGN_EPI) { if (wr == 1) PG8_BAR; }
    }
    PG8_WAIT_V(0);
    if constexpr (!ALIGN_EPI) { if (wr == 0) PG8_BAR; }
    PG8_BAR;
    if constexpr (Epi::AFTER_DRAIN) { E.fused(acc, cur, wr, wc, fr, fq, lds, wid, lane); S.done(cur); }
#undef PG8_SA
#undef PG8_SB
#undef PG8_STAGE
#undef PG8_LDA
#undef PG8_LDB
#undef PG8_MMA
#undef PG8_WAIT_V
#undef PG8_WAIT_L
#undef PG8_BAR
#undef PG8_SCHED
}
}

#define LAS __attribute__((address_space(3)))
typedef unsigned short bf16;
typedef float f32x4 __attribute__((ext_vector_type(4)));
typedef float f32x16 __attribute__((ext_vector_type(16)));
typedef unsigned u32x4 __attribute__((ext_vector_type(4)));
typedef unsigned u32x2 __attribute__((ext_vector_type(2)));
typedef short bf16x8 __attribute__((ext_vector_type(8)));

constexpr int NTOK = 16384, DM = 1024, SEQ = 8192, NPROJ = 2304, NPQ = 2048, NEXP = 16384;
constexpr float DN_ALPHA = 1.189207115002721f;
constexpr float LN_EPS = 1e-5f;
constexpr float LOG2E = 1.4426950408889634f;
constexpr int NWAVES = 8, NTHREADS = 512;
constexpr int LDS_BYTES = 147456;

constexpr size_t MiB = 1u << 20;
constexpr size_t WS_CTL = 0, WS_WIN = 1 * MiB, WS_WOUT = 6 * MiB, WS_WPQ = 8 * MiB, WS_CS = 12 * MiB;
constexpr size_t WS_UB = 16 * MiB, WS_VB = 48 * MiB, WS_XB = 80 * MiB, WS_Y = 80 * MiB;
constexpr size_t WS_PROJ = 112 * MiB, WS_H1F = 112 * MiB, WS_H1B = 184 * MiB, WS_EIDX = 216 * MiB, WS_GATE = 224 * MiB, WS_END = 232 * MiB;

struct Params {
    const float* x; const int* pos; const float* w_in; const float* b_in; const float* sinks; const float* conv_w; const float* w_out; const float* b_out;
    const float* ln1g; const float* ln1b; const float* w_pq; const float* sk1; const float* sk2; const float* ue; const float* ve; const float* ln2g; const float* ln2b;
    float* out; unsigned char* ws;
};

__device__ __forceinline__ unsigned f2bf(float f) { unsigned u = __builtin_bit_cast(unsigned, f); return (u + 0x7fffu + ((u >> 16) & 1u)) >> 16; }
__device__ __forceinline__ unsigned pk2(float lo, float hi) { return f2bf(lo) | (f2bf(hi) << 16); }
__device__ __forceinline__ float bf_lo(unsigned w) { return __builtin_bit_cast(float, w << 16); }
__device__ __forceinline__ float bf_hi(unsigned w) { return __builtin_bit_cast(float, w & 0xffff0000u); }
__device__ __forceinline__ float wave_sum(float v) {
#pragma unroll
    for (int o = 1; o < 64; o <<= 1) v += __shfl_xor(v, o);
    return v;
}

__constant__ double ROPE_INVF[8] = {1.0, 0.19392274474868576, 0.03760603093086393, 0.007292664737217109, 0.001414213562373095, 0.0002742481756762073, 5.318295896944988e-05, 1.031338537721246e-05};

namespace pg8 {
struct EpiProj {
    static constexpr bool PERM = true, AFTER_DRAIN = false;
    bf16_t* O; const float* bias; const float* cs;
    __device__ __forceinline__ void operator()(const f32x4 (&acc)[2][2][4][2], const Unit& u, int wr, int wc, int fr, int fq) const {
        const int row0 = u.pm * BM + wr * 64 + fr;
        const int col0 = u.pn * BM + wc * 32 + 8 * fq;
        f32x4 bv[2][2];
#pragma unroll
        for (int bj = 0; bj < 2; ++bj)
#pragma unroll
            for (int n = 0; n < 2; ++n) bv[bj][n] = *(const f32x4*)(bias + col0 + bj * HALF + 4 * n);
        const bool rope_wave = (u.pn <= 2) && ((wc & 1) == 0);
#pragma unroll
        for (int ai = 0; ai < 2; ++ai)
#pragma unroll
            for (int m = 0; m < 4; ++m) {
                const int row = row0 + ai * HALF + m * 16;
                bf16_t* rowp = O + (size_t)row * 2304 + col0;
                f32x4 c0 = {1.f, 0.f, 1.f, 0.f}, c1 = c0, c2 = c0, c3 = c0;
                if (rope_wave && fq < 2) { const f32x4* cp = (const f32x4*)(cs + (size_t)row * 16); c0 = cp[0]; c1 = cp[1]; c2 = cp[2]; c3 = cp[3]; }
#pragma unroll
                for (int bj = 0; bj < 2; ++bj) {
                    f32x4 v0 = acc[ai][bj][m][0] + bv[bj][0], v1 = acc[ai][bj][m][1] + bv[bj][1];
                    if (rope_wave && (u.pn < 2 || bj == 0)) {
                        f32x4 p0, p1;
#pragma unroll
                        for (int e = 0; e < 4; ++e) { p0[e] = __shfl_xor(v0[e], 16); p1[e] = __shfl_xor(v1[e], 16); }
                        if (fq < 2) {
                            const float sg = (fq == 0) ? -1.f : 1.f;
                            v0[0] = v0[0] * c0[0] + sg * p0[0] * c0[1]; v0[1] = v0[1] * c0[2] + sg * p0[1] * c0[3];
                            v0[2] = v0[2] * c1[0] + sg * p0[2] * c1[1]; v0[3] = v0[3] * c1[2] + sg * p0[3] * c1[3];
                            v1[0] = v1[0] * c2[0] + sg * p1[0] * c2[1]; v1[1] = v1[1] * c2[2] + sg * p1[1] * c2[3];
                            v1[2] = v1[2] * c3[0] + sg * p1[2] * c3[1]; v1[3] = v1[3] * c3[2] + sg * p1[3] * c3[3];
                        }
                    }
                    u32x4 w; w.x = cvt_pk_bf16(v0[0], v0[1]); w.y = cvt_pk_bf16(v0[2], v0[3]); w.z = cvt_pk_bf16(v1[0], v1[1]); w.w = cvt_pk_bf16(v1[2], v1[3]);
                    *(u32x4*)(rowp + bj * HALF) = w;
                }
            }
    }
};
struct EpiF32 {
    static constexpr bool PERM = false, AFTER_DRAIN = false;
    float* O; int ldc; const float* bias;
    __device__ __forceinline__ void operator()(const f32x4 (&acc)[2][2][4][2], const Unit& u, int wr, int wc, int fr, int fq) const {
        const int row0 = u.pm * BM + wr * 64 + fr;
        const int col0 = u.pn * BM + wc * 32 + 4 * fq;
#pragma unroll
        for (int bj = 0; bj < 2; ++bj)
#pragma unroll
            for (int n = 0; n < 2; ++n) {
                const f32x4 bv = *(const f32x4*)(bias + col0 + bj * HALF + n * 16);
#pragma unroll
                for (int ai = 0; ai < 2; ++ai)
#pragma unroll
                    for (int m = 0; m < 4; ++m) *(f32x4*)(O + (size_t)(row0 + ai * HALF + m * 16) * ldc + col0 + bj * HALF + n * 16) = acc[ai][bj][m][n] + bv;
            }
    }
};
}

__device__ __forceinline__ void p0_transpose_item(const float* W, int K, int N, bf16* WT, LAS float* scr, int item, int lane) {
    const int nblk = N / 32, kb = item / nblk, nb = item % nblk, k0 = 64 * kb, n0 = 32 * nb;
#pragma unroll 8
    for (int i = 0; i < 32; ++i) { const int kk = 2 * i + (lane >> 5); scr[kk * 33 + (lane & 31)] = W[(size_t)(k0 + kk) * N + n0 + (lane & 31)]; }
    asm volatile("s_waitcnt lgkmcnt(0)" ::: "memory");
    const int c = lane & 7;
#pragma unroll
    for (int j = 0; j < 4; ++j) { const int n = (lane >> 3) + 8 * j; const LAS float* s = scr + (8 * c) * 33 + n;
        u32x4 o; o.x = pk2(s[0 * 33], s[1 * 33]); o.y = pk2(s[2 * 33], s[3 * 33]); o.z = pk2(s[4 * 33], s[5 * 33]); o.w = pk2(s[6 * 33], s[7 * 33]);
        *(u32x4*)(WT + (size_t)(n0 + n) * K + k0 + 8 * c) = o; }
    asm volatile("s_waitcnt lgkmcnt(0)" ::: "memory");
}
__device__ __forceinline__ void row_to_bf16(const float* src, bf16* dst, int lane) {
    const f32x4* s = (const f32x4*)src + lane; unsigned long long* o = (unsigned long long*)dst + lane;
#pragma unroll
    for (int j = 0; j < 4; ++j) { const f32x4 v = s[64 * j]; o[64 * j] = (unsigned long long)pk2(v.x, v.y) | ((unsigned long long)pk2(v.z, v.w) << 32); }
}
__device__ __forceinline__ void phase_prologue(const Params& P, LAS unsigned char* lds) {
    const int tid = threadIdx.x, lane = tid & 63, wave = __builtin_amdgcn_readfirstlane(tid >> 6);
    const int gw = blockIdx.x * NWAVES + wave, NGW = gridDim.x * NWAVES;
    LAS float* scr = (LAS float*)(lds + wave * 16384);
    constexpr int I_IN = 16 * (NPROJ / 32), I_OUT = 16 * (DM / 32), I_PQ = 16 * (NPQ / 32);
    for (int it = gw; it < I_IN + I_OUT + I_PQ; it += NGW) {
        int r = it;
        if (r < I_IN) { p0_transpose_item(P.w_in, DM, NPROJ, (bf16*)(P.ws + WS_WIN), scr, r, lane); continue; } r -= I_IN;
        if (r < I_OUT) { p0_transpose_item(P.w_out, DM, DM, (bf16*)(P.ws + WS_WOUT), scr, r, lane); continue; } r -= I_OUT;
        p0_transpose_item(P.w_pq, DM, NPQ, (bf16*)(P.ws + WS_WPQ), scr, r, lane);
    }
    for (int m = gw; m < 3 * NTOK; m += NGW) {
        const int which = m >> 14, r = m & 16383;
        const float* src = (which == 0 ? P.x : which == 1 ? P.ue : P.ve) + (size_t)r * DM;
        bf16* dst = (bf16*)(P.ws + (which == 0 ? WS_XB : which == 1 ? WS_UB : WS_VB)) + (size_t)r * DM;
        row_to_bf16(src, dst, lane);
    }
    float* cs = (float*)(P.ws + WS_CS);
    for (int e = blockIdx.x * NTHREADS + tid; e < NTOK * 8; e += gridDim.x * NTHREADS) {
        const int t = e >> 3, i = e & 7;
        const double ang = (double)P.pos[t] * ROPE_INVF[i];
        double sn, cn; sincos(ang, &sn, &cn);
        cs[2 * e] = (float)cn; cs[2 * e + 1] = (float)sn;
    }
}

__device__ __forceinline__ void phase_attn(const Params& P, LAS unsigned char* lds) {
    const int tid = threadIdx.x, lane = tid & 63, wave = __builtin_amdgcn_readfirstlane(tid >> 6), r = lane & 31, h = lane >> 5;
    const bf16* proj = (const bf16*)(P.ws + WS_PROJ); bf16* y = (bf16*)(P.ws + WS_Y);
    LAS unsigned char* Kl = lds;
    LAS unsigned char* Vt = lds + 36864;
    for (int unit = blockIdx.x; unit < 256; unit += gridDim.x) {
        const int b = unit >> 7, n = (unit >> 1) & 63, hk = unit & 1;
        const int tok0 = b * SEQ + n * 128;
        __syncthreads();
#pragma unroll
        for (int i = 0; i < 4; ++i) {
            const int row = (tid >> 3) + 64 * i, ch = tid & 7;
            const bool valid = (n > 0) || (row >= 128);
            u32x4 kv = {0u, 0u, 0u, 0u}, vv = {0u, 0u, 0u, 0u};
            if (valid) { const bf16* src = proj + (size_t)(tok0 - 128 + row) * NPROJ + 512 + hk * 64 + ch * 8; kv = *(const u32x4*)src; vv = *(const u32x4*)(src + 128); }
            *(LAS u32x4*)(Kl + row * 144 + ch * 16) = kv;
            LAS unsigned short* vt = (LAS unsigned short*)(Vt + (ch * 8) * 520 + row * 2);
            vt[0 * 260] = (unsigned short)(vv.x & 0xffffu); vt[1 * 260] = (unsigned short)(vv.x >> 16);
            vt[2 * 260] = (unsigned short)(vv.y & 0xffffu); vt[3 * 260] = (unsigned short)(vv.y >> 16);
            vt[4 * 260] = (unsigned short)(vv.z & 0xffffu); vt[5 * 260] = (unsigned short)(vv.z >> 16);
            vt[6 * 260] = (unsigned short)(vv.w & 0xffffu); vt[7 * 260] = (unsigned short)(vv.w >> 16);
        }
        __syncthreads();
        const int g = wave >> 1, qh = wave & 1, head = hk * 4 + g;
        const float sink = P.sinks[head];
#pragma unroll 1
        for (int blk = 0; blk < 2; ++blk) {
            const int qb = 2 * qh + blk, q0 = 32 * qb;
            const bf16* qp = proj + (size_t)(tok0 + q0 + r) * NPROJ + head * 64 + 8 * h;
            bf16x8 qf[4];
#pragma unroll
            for (int s = 0; s < 4; ++s) qf[s] = *(const bf16x8*)(qp + 16 * s);
            f32x16 st[5];
#pragma unroll
            for (int kt5 = 0; kt5 < 5; ++kt5) {
                f32x16 acc;
#pragma unroll
                for (int i = 0; i < 16; ++i) acc[i] = 0.f;
                const LAS unsigned char* kp = Kl + ((qb + kt5) * 32 + r) * 144 + 16 * h;
#pragma unroll
                for (int s = 0; s < 4; ++s) { const bf16x8 a = *(const LAS bf16x8*)(kp + 32 * s); acc = __builtin_amdgcn_mfma_f32_32x32x16_bf16(a, qf[s], acc, 0, 0, 0); }
                st[kt5] = acc;
            }
            float mx = -INFINITY;
#pragma unroll
            for (int kt5 = 0; kt5 < 5; ++kt5)
#pragma unroll
                for (int i = 0; i < 16; ++i) {
                    const int keyrow = (i & 3) + 8 * (i >> 2) + 4 * h;
                    const int kj = (qb + kt5) * 32 + keyrow, rel = 32 * kt5 + keyrow - r;
                    const bool valid = (rel >= 1) && (rel <= 128) && (n > 0 || kj >= 128);
                    const float v = valid ? st[kt5][i] * 0.125f : -INFINITY;
                    st[kt5][i] = v; mx = fmaxf(mx, v);
                }
            mx = fmaxf(mx, __shfl_xor(mx, 32)); mx = fmaxf(mx, sink);
            float l = 0.f;
#pragma unroll
            for (int kt5 = 0; kt5 < 5; ++kt5)
#pragma unroll
                for (int i = 0; i < 16; ++i) { const float p = exp2f((st[kt5][i] - mx) * LOG2E); st[kt5][i] = p; l += p; }
            l += __shfl_xor(l, 32); l += exp2f((sink - mx) * LOG2E);
            f32x16 ot[2];
#pragma unroll
            for (int i = 0; i < 16; ++i) { ot[0][i] = 0.f; ot[1][i] = 0.f; }
#pragma unroll
            for (int kt5 = 0; kt5 < 5; ++kt5)
#pragma unroll
                for (int s2 = 0; s2 < 2; ++s2) {
                    u32x4 w; w.x = pk2(st[kt5][8 * s2 + 0], st[kt5][8 * s2 + 1]); w.y = pk2(st[kt5][8 * s2 + 2], st[kt5][8 * s2 + 3]);
                    w.z = pk2(st[kt5][8 * s2 + 4], st[kt5][8 * s2 + 5]); w.w = pk2(st[kt5][8 * s2 + 6], st[kt5][8 * s2 + 7]);
                    const bf16x8 pb = __builtin_bit_cast(bf16x8, w);
                    const int base = (qb + kt5) * 32 + 16 * s2 + 4 * h;
#pragma unroll
                    for (int dblk = 0; dblk < 2; ++dblk) {
                        const LAS unsigned char* vp = Vt + (32 * dblk + r) * 520 + base * 2;
                        const u32x2 lo = *(const LAS u32x2*)vp, hi = *(const LAS u32x2*)(vp + 16);
                        u32x4 aw; aw.x = lo.x; aw.y = lo.y; aw.z = hi.x; aw.w = hi.y;
                        ot[dblk] = __builtin_amdgcn_mfma_f32_32x32x16_bf16(__builtin_bit_cast(bf16x8, aw), pb, ot[dblk], 0, 0, 0);
                    }
                }
            const float inv = 1.f / l;
            bf16* yp = y + (size_t)(tok0 + q0 + r) * DM + head * 64;
#pragma unroll
            for (int dblk = 0; dblk < 2; ++dblk)
#pragma unroll
                for (int g4 = 0; g4 < 4; ++g4) {
                    u32x2 o; o.x = pk2(ot[dblk][4 * g4] * inv, ot[dblk][4 * g4 + 1] * inv); o.y = pk2(ot[dblk][4 * g4 + 2] * inv, ot[dblk][4 * g4 + 3] * inv);
                    *(u32x2*)(yp + 32 * dblk + 8 * g4 + 4 * h) = o;
                }
        }
        {
            const int cc = tid & 31, tg = tid >> 5, c0 = 256 * hk + 8 * cc;
            float w0[8], w1[8], w2[8], p1[8], p2[8];
#pragma unroll
            for (int e = 0; e < 8; ++e) { w0[e] = P.conv_w[c0 + e]; w1[e] = P.conv_w[512 + c0 + e]; w2[e] = P.conv_w[1024 + c0 + e]; p1[e] = 0.f; p2[e] = 0.f; }
            const int tl0 = 128 * n + 8 * tg;
#pragma unroll
            for (int k = 2; k >= 1; --k) {
                const int tloc = tl0 - k;
                if (tloc >= 0) {
                    const bf16* src = proj + (size_t)(b * SEQ + tloc) * NPROJ + c0;
                    const u32x4 gc = *(const u32x4*)(src + 1280), xc = *(const u32x4*)(src + 1792);
                    float pv[8];
                    pv[0] = bf_lo(gc.x) * bf_lo(xc.x); pv[1] = bf_hi(gc.x) * bf_hi(xc.x); pv[2] = bf_lo(gc.y) * bf_lo(xc.y); pv[3] = bf_hi(gc.y) * bf_hi(xc.y);
                    pv[4] = bf_lo(gc.z) * bf_lo(xc.z); pv[5] = bf_hi(gc.z) * bf_hi(xc.z); pv[6] = bf_lo(gc.w) * bf_lo(xc.w); pv[7] = bf_hi(gc.w) * bf_hi(xc.w);
#pragma unroll
                    for (int e = 0; e < 8; ++e) { if (k == 2) p2[e] = pv[e]; else p1[e] = pv[e]; }
                }
            }
#pragma unroll 2
            for (int j = 0; j < 8; ++j) {
                const size_t row = (size_t)(b * SEQ + tl0 + j);
                const bf16* src = proj + row * NPROJ + c0;
                const u32x4 gb = *(const u32x4*)(src + 768), gc = *(const u32x4*)(src + 1280), xc = *(const u32x4*)(src + 1792);
                float p0[8], gbf[8], o[8];
                p0[0] = bf_lo(gc.x) * bf_lo(xc.x); p0[1] = bf_hi(gc.x) * bf_hi(xc.x); p0[2] = bf_lo(gc.y) * bf_lo(xc.y); p0[3] = bf_hi(gc.y) * bf_hi(xc.y);
                p0[4] = bf_lo(gc.z) * bf_lo(xc.z); p0[5] = bf_hi(gc.z) * bf_hi(xc.z); p0[6] = bf_lo(gc.w) * bf_lo(xc.w); p0[7] = bf_hi(gc.w) * bf_hi(xc.w);
                gbf[0] = bf_lo(gb.x); gbf[1] = bf_hi(gb.x); gbf[2] = bf_lo(gb.y); gbf[3] = bf_hi(gb.y); gbf[4] = bf_lo(gb.z); gbf[5] = bf_hi(gb.z); gbf[6] = bf_lo(gb.w); gbf[7] = bf_hi(gb.w);
#pragma unroll
                for (int e = 0; e < 8; ++e) { o[e] = gbf[e] * (w0[e] * p2[e] + w1[e] * p1[e] + w2[e] * p0[e]); p2[e] = p1[e]; p1[e] = p0[e]; }
                u32x4 ow; ow.x = pk2(o[0], o[1]); ow.y = pk2(o[2], o[3]); ow.z = pk2(o[4], o[5]); ow.w = pk2(o[6], o[7]);
                *(u32x4*)(y + row * DM + 512 + c0) = ow;
            }
        }
    }
}

__device__ __forceinline__ void phase_ln1(const Params& P, const float* mix) {
    const int tid = threadIdx.x, lane = tid & 63, wave = __builtin_amdgcn_readfirstlane(tid >> 6);
    const int gw = blockIdx.x * NWAVES + wave, NGW = gridDim.x * NWAVES;
    float* h1f = (float*)(P.ws + WS_H1F); bf16* h1b = (bf16*)(P.ws + WS_H1B);
    f32x4 gg[4], bb[4];
#pragma unroll
    for (int j = 0; j < 4; ++j) { gg[j] = ((const f32x4*)P.ln1g)[lane + 64 * j]; bb[j] = ((const f32x4*)P.ln1b)[lane + 64 * j]; }
    for (int m = gw; m < NTOK; m += NGW) {
        const f32x4* xr = (const f32x4*)(P.x + (size_t)m * DM) + lane; const f32x4* mr = (const f32x4*)(mix + (size_t)m * DM) + lane;
        f32x4 v[4]; float s = 0.f;
#pragma unroll
        for (int j = 0; j < 4; ++j) { v[j] = xr[64 * j] * DN_ALPHA + mr[64 * j]; s += (v[j].x + v[j].y) + (v[j].z + v[j].w); }
        const float mean = wave_sum(s) * (1.f / DM); float s2 = 0.f;
#pragma unroll
        for (int j = 0; j < 4; ++j) { v[j] = v[j] - mean; s2 += (v[j].x * v[j].x + v[j].y * v[j].y) + (v[j].z * v[j].z + v[j].w * v[j].w); }
        const float rstd = 1.f / sqrtf(wave_sum(s2) * (1.f / DM) + LN_EPS);
        f32x4* of = (f32x4*)(h1f + (size_t)m * DM) + lane; unsigned long long* ob = (unsigned long long*)(h1b + (size_t)m * DM) + lane;
#pragma unroll
        for (int j = 0; j < 4; ++j) { const f32x4 o = v[j] * rstd * gg[j] + bb[j]; of[64 * j] = o; ob[64 * j] = (unsigned long long)pk2(o.x, o.y) | ((unsigned long long)pk2(o.z, o.w) << 32); }
    }
}

__device__ __forceinline__ int tokey(float f) { const int u = __builtin_bit_cast(int, f); return u ^ ((u >> 31) & 0x7fffffff); }
__device__ __forceinline__ float fromkey(int k) { const int u = k ^ ((k >> 31) & 0x7fffffff); return __builtin_bit_cast(float, u); }
#define CSWAP_DESC(a, b) do { const int _x = (a), _y = (b); (a) = _x > _y ? _x : _y; (b) = _x > _y ? _y : _x; } while (0)
__device__ __forceinline__ void sort16_desc(int (&v)[16]) {
#pragma unroll
    for (int k = 2; k <= 16; k <<= 1)
#pragma unroll
        for (int j = k >> 1; j > 0; j >>= 1)
#pragma unroll
            for (int i = 0; i < 16; ++i) { const int l = i ^ j; if (l > i) { if ((i & k) == 0) CSWAP_DESC(v[i], v[l]); else CSWAP_DESC(v[l], v[i]); } }
}
__device__ __forceinline__ void merge16(int (&a)[16], const int (&b)[16]) {
#pragma unroll
    for (int i = 0; i < 16; ++i) a[i] = a[i] > b[15 - i] ? a[i] : b[15 - i];
#pragma unroll
    for (int j = 8; j > 0; j >>= 1)
#pragma unroll
        for (int i = 0; i < 16; ++i) { const int l = i ^ j; if (l > i) CSWAP_DESC(a[i], a[l]); }
}
__device__ __forceinline__ void top16_of_64(const int (&k)[64], int (&out)[16]) {
    int g1[16], g2[16], g3[16];
#pragma unroll
    for (int i = 0; i < 16; ++i) { out[i] = k[i]; g1[i] = k[16 + i]; g2[i] = k[32 + i]; g3[i] = k[48 + i]; }
    sort16_desc(out); sort16_desc(g1); sort16_desc(g2); sort16_desc(g3);
    merge16(out, g1); merge16(g2, g3); merge16(out, g2);
}
struct CandTab { int ci[64]; int cj[64]; int n; };
constexpr CandTab make_cand() { CandTab t{}; int n = 0; for (int i = 0; i < 16; ++i) for (int j = 0; j < 16; ++j) if ((i + 1) * (j + 1) <= 16) { t.ci[n] = i; t.cj[n] = j; ++n; } t.n = n; return t; }
constexpr CandTab CT = make_cand();
static_assert(CT.n == 50, "staircase candidates");

constexpr int TK_SKP = 272;
constexpr int TK_SK2 = 128 * TK_SKP, TK_SCR = 2 * 128 * TK_SKP;

__device__ __forceinline__ void phase_topk(const Params& P, LAS unsigned char* lds, const bf16* qpeer) {
    const int tid = threadIdx.x, lane = tid & 63, wave = __builtin_amdgcn_readfirstlane(tid >> 6), r = lane & 31, h = lane >> 5;
    int* eidx = (int*)(P.ws + WS_EIDX); float* gate = (float*)(P.ws + WS_GATE);
    __syncthreads();
    for (int e = tid; e < 2 * 128 * 32; e += NTHREADS) {
        const int which = e >> 12, rem = e & 4095, row = rem >> 5, c4 = rem & 31;
        const f32x4 v = *(const f32x4*)((which ? P.sk2 : P.sk1) + row * 128 + c4 * 4);
        u32x2 w; w.x = pk2(v.x, v.y); w.y = pk2(v.z, v.w);
        *(LAS u32x2*)(lds + which * TK_SK2 + row * TK_SKP + c4 * 8) = w;
    }
    __syncthreads();
    LAS int* scr = (LAS int*)(lds + TK_SCR + wave * 8192);
    for (int task = blockIdx.x * NWAVES + wave; task < 2048; task += gridDim.x * NWAVES) {
        const int tb = task >> 2, hp = task & 3;
        int L[2][2][16];
#pragma unroll
        for (int hh = 0; hh < 2; ++hh)
#pragma unroll
            for (int half = 0; half < 2; ++half) {
                const int head = 2 * hp + hh;
                asm volatile("" ::: "memory"); __builtin_amdgcn_sched_barrier(0);
                const bf16* qp = qpeer + (size_t)(32 * tb + r) * NPQ + 256 * head + 128 * half + 8 * h;
                bf16x8 qf[8];
#pragma unroll
                for (int s = 0; s < 8; ++s) qf[s] = *(const bf16x8*)(qp + 16 * s);
#pragma unroll
                for (int kt = 0; kt < 4; ++kt) {
                    __builtin_amdgcn_sched_barrier(0);
                    f32x16 acc;
#pragma unroll
                    for (int i = 0; i < 16; ++i) acc[i] = 0.f;
                    const LAS unsigned char* kp = lds + half * TK_SK2 + (kt * 32 + r) * TK_SKP + 16 * h;
#pragma unroll
                    for (int s = 0; s < 8; ++s) { const bf16x8 a = *(const LAS bf16x8*)(kp + 32 * s); acc = __builtin_amdgcn_mfma_f32_32x32x16_bf16(a, qf[s], acc, 0, 0, 0); }
                    int tk[16];
#pragma unroll
                    for (int i = 0; i < 16; ++i) { const int idx = kt * 32 + (i & 3) + 8 * (i >> 2) + 4 * h; tk[i] = (tokey(acc[i]) & ~127) | idx; }
                    sort16_desc(tk);
                    if (kt == 0) {
#pragma unroll
                        for (int i = 0; i < 16; ++i) L[hh][half][i] = tk[i];
                    } else merge16(L[hh][half], tk);
                }
            }
        int a[16], b[16];
#pragma unroll
        for (int half = 0; half < 2; ++half) {
            int own[16], oth[16];
#pragma unroll
            for (int i = 0; i < 16; ++i) {
                const int send = h ? L[0][half][i] : L[1][half][i];
                own[i] = h ? L[1][half][i] : L[0][half][i];
                oth[i] = __shfl_xor(send, 32);
            }
            merge16(own, oth);
#pragma unroll
            for (int i = 0; i < 16; ++i) { if (half == 0) a[i] = own[i]; else b[i] = own[i]; }
        }
        float fa[16], fb[16];
#pragma unroll
        for (int i = 0; i < 16; ++i) { fa[i] = fromkey(a[i] & ~127); fb[i] = fromkey(b[i] & ~127); scr[i * 64 + lane] = a[i] & 127; scr[(16 + i) * 64 + lane] = b[i] & 127; }
        int top[16];
#pragma unroll
        for (int gq = 0; gq < 4; ++gq) {
            __builtin_amdgcn_sched_barrier(0);
            int ck[16];
#pragma unroll
            for (int s2 = 0; s2 < 16; ++s2) {
                const int s = gq * 16 + s2;
                if (s < CT.n) ck[s2] = (tokey(fa[CT.ci[s]] + fb[CT.cj[s]]) & ~255) | (CT.ci[s] << 4) | CT.cj[s];
                else ck[s2] = (int)0x80000000;
            }
            sort16_desc(ck);
            if (gq == 0) {
#pragma unroll
                for (int i = 0; i < 16; ++i) top[i] = ck[i];
            } else merge16(top, ck);
        }
        float sc[16]; float ssum = 0.f;
        const float m0 = fromkey(top[0] & ~255);
#pragma unroll
        for (int i = 0; i < 16; ++i) { sc[i] = exp2f((fromkey(top[i] & ~255) - m0) * LOG2E); ssum += sc[i]; }
        const float rs = 1.f / ssum;
        const int head = 2 * hp + h;
        int* eo = eidx + ((size_t)(32 * tb + r) * 8 + head) * 16; float* go = gate + ((size_t)(32 * tb + r) * 8 + head) * 16;
#pragma unroll
        for (int q = 0; q < 4; ++q) {
            u32x4 ev; f32x4 gv;
#pragma unroll
            for (int e = 0; e < 4; ++e) {
                const int code = top[4 * q + e] & 255;
                const int i1 = scr[(code >> 4) * 64 + lane], i2 = scr[(16 + (code & 15)) * 64 + lane];
                ev[e] = (unsigned)(i1 * 128 + i2); gv[e] = sc[4 * q + e] * rs;
            }
            *(u32x4*)(eo + 4 * q) = ev; *(f32x4*)(go + 4 * q) = gv;
        }
    }
}

__device__ __forceinline__ float gelu_erf(float v) { return 0.5f * v * (1.f + erff(v * 0.70710678118654752f)); }
__device__ __forceinline__ void unpack8(const u32x4 w, float* f) {
    f[0] = bf_lo(w.x); f[1] = bf_hi(w.x); f[2] = bf_lo(w.y); f[3] = bf_hi(w.y); f[4] = bf_lo(w.z); f[5] = bf_hi(w.z); f[6] = bf_lo(w.w); f[7] = bf_hi(w.w);
}
__device__ __forceinline__ void phase_expert(const Params& P) {
    const int tid = threadIdx.x, lane = tid & 63, wave = __builtin_amdgcn_readfirstlane(tid >> 6);
    const int gw = blockIdx.x * NWAVES + wave, NGW = gridDim.x * NWAVES;
    const bf16* ub = (const bf16*)(P.ws + WS_UB); const bf16* vb = (const bf16*)(P.ws + WS_VB);
    const float* h1f = (const float*)(P.ws + WS_H1F); const bf16* h1b = (const bf16*)(P.ws + WS_H1B);
    const int* eidx = (const int*)(P.ws + WS_EIDX); const float* gate = (const float*)(P.ws + WS_GATE);
    for (int tj = 0; tj < 8; ++tj) {
        const int t = 64 * (int)blockIdx.x + 8 * wave + tj;
        float hf[16];
        unpack8(*(const u32x4*)(h1b + (size_t)t * DM + 8 * lane), hf); unpack8(*(const u32x4*)(h1b + (size_t)t * DM + 512 + 8 * lane), hf + 8);
        float acc[16];
#pragma unroll
        for (int e = 0; e < 16; ++e) acc[e] = 0.f;
        const int e_lo = eidx[(size_t)t * 128 + lane], e_hi = eidx[(size_t)t * 128 + 64 + lane];
        const float g_lo = gate[(size_t)t * 128 + lane], g_hi = gate[(size_t)t * 128 + 64 + lane];
#pragma unroll 1
        for (int k0 = 0; k0 < 128; k0 += 4) {
            int ex[4]; float gx[4]; u32x4 ua[4], ubv[4], va[4], vbv[4];
#pragma unroll
            for (int j = 0; j < 4; ++j) {
                const int k = k0 + j;
                ex[j] = __shfl(k < 64 ? e_lo : e_hi, k & 63); gx[j] = __shfl(k < 64 ? g_lo : g_hi, k & 63);
                const bf16* up = ub + (size_t)ex[j] * DM + 8 * lane; const bf16* vp = vb + (size_t)ex[j] * DM + 8 * lane;
                ua[j] = *(const u32x4*)up; ubv[j] = *(const u32x4*)(up + 512); va[j] = *(const u32x4*)vp; vbv[j] = *(const u32x4*)(vp + 512);
            }
            float d[4];
#pragma unroll
            for (int j = 0; j < 4; ++j) {
                float uf[16]; unpack8(ua[j], uf); unpack8(ubv[j], uf + 8);
                float s = 0.f;
#pragma unroll
                for (int e = 0; e < 16; ++e) s += uf[e] * hf[e];
                d[j] = s;
            }
#pragma unroll
            for (int o = 1; o < 64; o <<= 1) {
#pragma unroll
                for (int j = 0; j < 4; ++j) d[j] += __shfl_xor(d[j], o);
            }
#pragma unroll
            for (int j = 0; j < 4; ++j) {
                const float w = gx[j] * gelu_erf(d[j]);
                float vf[16]; unpack8(va[j], vf); unpack8(vbv[j], vf + 8);
#pragma unroll
                for (int e = 0; e < 16; ++e) acc[e] += w * vf[e];
            }
        }
        const float* hr = h1f + (size_t)t * DM;
        float v[16];
        { const f32x4 a0 = *(const f32x4*)(hr + 8 * lane), a1 = *(const f32x4*)(hr + 8 * lane + 4), b0 = *(const f32x4*)(hr + 512 + 8 * lane), b1 = *(const f32x4*)(hr + 512 + 8 * lane + 4);
          v[0] = a0.x; v[1] = a0.y; v[2] = a0.z; v[3] = a0.w; v[4] = a1.x; v[5] = a1.y; v[6] = a1.z; v[7] = a1.w;
          v[8] = b0.x; v[9] = b0.y; v[10] = b0.z; v[11] = b0.w; v[12] = b1.x; v[13] = b1.y; v[14] = b1.z; v[15] = b1.w; }
        float s = 0.f;
#pragma unroll
        for (int e = 0; e < 16; ++e) { v[e] = v[e] * DN_ALPHA + acc[e]; s += v[e]; }
        const float mean = wave_sum(s) * (1.f / DM); float s2 = 0.f;
#pragma unroll
        for (int e = 0; e < 16; ++e) { v[e] -= mean; s2 += v[e] * v[e]; }
        const float rstd = 1.f / sqrtf(wave_sum(s2) * (1.f / DM) + LN_EPS);
        float* orow = P.out + (size_t)t * DM;
#pragma unroll
        for (int q = 0; q < 4; ++q) {
            const int c = (q >> 1) * 512 + 8 * lane + (q & 1) * 4;
            const f32x4 gg = *(const f32x4*)(P.ln2g + c), bb = *(const f32x4*)(P.ln2b + c);
            f32x4 o; o.x = v[4 * q] * rstd * gg.x + bb.x; o.y = v[4 * q + 1] * rstd * gg.y + bb.y; o.z = v[4 * q + 2] * rstd * gg.z + bb.z; o.w = v[4 * q + 3] * rstd * gg.w + bb.w;
            *(f32x4*)(orow + c) = o;
        }
    }
}


#define XB_TMO      128
#define XB_XCNT(j)  (256  + 64 * (j))
#define XB_XSUB(j)  (1280 + 64 * (j))
#define XB_XGEN(j)  (2304 + 64 * (j))
#define XB_TOP      3328
#define XB_TOPGEN   3392
#define XCD_BAR_WORDS 3456
#define XB_SPIN_CAP (1u << 18)

__device__ __forceinline__ unsigned xb_ld(unsigned* p)              { return __hip_atomic_load(p, __ATOMIC_RELAXED, __HIP_MEMORY_SCOPE_AGENT); }
__device__ __forceinline__ unsigned xb_add(unsigned* p, unsigned v) { return __hip_atomic_fetch_add(p, v, __ATOMIC_RELAXED, __HIP_MEMORY_SCOPE_AGENT); }
__device__ __forceinline__ unsigned xb_xcc_id() { return (unsigned)__builtin_amdgcn_s_getreg((3 << 11) | 20) & 0xFu; }
#define XB_SPIN(cond, bar) do { unsigned _sp = 0; while (cond) { __builtin_amdgcn_s_sleep(1); \
    if ((++_sp & 255u) == 0u) { if (xb_ld(&(bar)[XB_TMO])) break; if (_sp > XB_SPIN_CAP) { atomicAdd(&(bar)[XB_TMO], 1u); break; } } } } while (0)

struct XcdBarrier {
    unsigned* bar; unsigned x;
    volatile LAS unsigned* st;
};

__device__ __forceinline__ XcdBarrier xcd_barrier_post(unsigned* bar, volatile LAS unsigned* st) {
    XcdBarrier b; b.bar = bar; b.x = xb_xcc_id(); b.st = st;
    if (threadIdx.x == 0) (void)xb_add(&bar[XB_XCNT(b.x)], 1u);
    return b;
}
__device__ __forceinline__ void xcd_barrier_complete(unsigned* bar, unsigned x, unsigned& nloc, unsigned& nx) {
    const unsigned G = gridDim.x * gridDim.y * gridDim.z;
    unsigned sum, cnt, mine, sp = 0u;
    for (;;) {
        sum = 0u; cnt = 0u; mine = 0u;
#pragma unroll
        for (unsigned j = 0; j < 16; ++j) { const unsigned c = xb_ld(&bar[XB_XCNT(j)]); sum += c; cnt += (c > 0u) ? 1u : 0u; mine = (j == x) ? c : mine; }
        if (sum == G) break;
        __builtin_amdgcn_s_sleep(1);
        if ((++sp & 255u) == 0u) { if (xb_ld(&bar[XB_TMO])) break; if (sp > XB_SPIN_CAP) { atomicAdd(&bar[XB_TMO], 1u); break; } }
    }
    nloc = mine > 0u ? mine : 1u; nx = cnt > 0u ? cnt : 1u;
}

__device__ __forceinline__ void xcd_barrier(const XcdBarrier& b) {
    asm volatile("s_waitcnt vmcnt(0)" ::: "memory");
    __syncthreads();
    if (threadIdx.x == 0) {
        unsigned* bar = b.bar;
        __builtin_amdgcn_s_waitcnt(0);
        unsigned nloc = b.st[0], nx = b.st[1];
        if (nloc == 0u) { xcd_barrier_complete(bar, b.x, nloc, nx); b.st[0] = nloc; b.st[1] = nx; }
        const unsigned old = xb_add(&bar[XB_XSUB(b.x)], 1u);
        const unsigned gen = old / nloc;
        if (old + 1u == (gen + 1u) * nloc) {
            __builtin_amdgcn_fence(__ATOMIC_RELEASE, "agent");
            asm volatile("s_waitcnt vmcnt(0)" ::: "memory");
            const unsigned og = xb_add(&bar[XB_TOP], 1u);
            const unsigned tg = og / nx;
            if (og + 1u == (tg + 1u) * nx) xb_add(&bar[XB_TOPGEN], 1u);
            else XB_SPIN(xb_ld(&bar[XB_TOPGEN]) == tg, bar);
            __builtin_amdgcn_fence(__ATOMIC_ACQUIRE, "agent");
            xb_add(&bar[XB_XGEN(b.x)], 1u);
            asm volatile("s_waitcnt vmcnt(0)" ::: "memory");
        } else {
            XB_SPIN(xb_ld(&bar[XB_XGEN(b.x)]) == gen, bar);
            __builtin_amdgcn_fence(__ATOMIC_ACQUIRE, "agent");
            asm volatile("s_waitcnt vmcnt(0)" ::: "memory");
        }
    }
    __syncthreads();
}

constexpr int MISC_OFF = LDS_BYTES - 256;
constexpr int CW_BAR = 4096;
constexpr size_t CTL_ZERO_BYTES = 65536;

__global__ void __launch_bounds__(NTHREADS, 2) fwd_megakernel(Params P) {
    extern __shared__ __attribute__((aligned(16))) unsigned char lds_raw[];
    LAS unsigned char* lds = (LAS unsigned char*)lds_raw;
    const int tid = threadIdx.x;
    volatile LAS unsigned* MISC = (volatile LAS unsigned*)(lds + MISC_OFF);
    if (tid < 64) MISC[tid] = 0u;
    __syncthreads();
    XcdBarrier bar = xcd_barrier_post((unsigned*)(P.ws + WS_CTL) + CW_BAR, MISC + 8);

    phase_prologue(P, lds);
    xcd_barrier(bar);
    { pg8::Gemm g{(const bf16*)(P.ws + WS_XB), (const bf16*)(P.ws + WS_WIN), NTOK, NPROJ, DM}; pg8::StaticOrder S; S.init(NTOK, NPROJ, gridDim.x, (int)blockIdx.x);
      pg8::EpiProj E{(bf16*)(P.ws + WS_PROJ), P.b_in, (const float*)(P.ws + WS_CS)};
      pg8::gemm_phase<pg8::EpiProj, pg8::StaticOrder, true, true>(lds, g, S, E); }
    xcd_barrier(bar);
    phase_attn(P, lds);
    xcd_barrier(bar);
    { pg8::Gemm g{(const bf16*)(P.ws + WS_Y), (const bf16*)(P.ws + WS_WOUT), NTOK, DM, DM}; pg8::StaticOrder S; S.init(NTOK, DM, gridDim.x, (int)blockIdx.x);
      pg8::EpiF32 E{P.out, DM, P.b_out};
      pg8::gemm_phase<pg8::EpiF32, pg8::StaticOrder, true, true>(lds, g, S, E); }
    xcd_barrier(bar);
    phase_ln1(P, P.out);
    xcd_barrier(bar);
    { pg8::Gemm g{(const bf16*)(P.ws + WS_H1B), (const bf16*)(P.ws + WS_WPQ), NTOK, NPQ, DM}; pg8::StaticOrder S; S.init(NTOK, NPQ, gridDim.x, (int)blockIdx.x);
      pg8::EpiBf16<0> E{(bf16*)P.out, NPQ, nullptr, 0, 0, 1.f};
      pg8::gemm_phase<pg8::EpiBf16<0>, pg8::StaticOrder, true, true>(lds, g, S, E); }
    xcd_barrier(bar);
    phase_topk(P, lds, (const bf16*)P.out);
    xcd_barrier(bar);
    phase_expert(P);
}

extern "C" void kernel_launch(void* const* d_in, const int* in_sizes, int n_in, void* d_out, int out_size, void* d_ws, size_t ws_size, hipStream_t stream) {
    static int grid = 0;
    if (grid == 0) {
        if (n_in != 17 || out_size != NTOK * DM || ws_size < WS_END) { fprintf(stderr, "kernel_launch: unexpected shapes (n_in %d out %d ws %zu)\n", n_in, out_size, ws_size); grid = -1; return; }
        int dev = 0, cus = 0, per_cu = 0;
        if (hipGetDevice(&dev) != hipSuccess || hipDeviceGetAttribute(&cus, hipDeviceAttributeMultiprocessorCount, dev) != hipSuccess) { grid = -1; return; }
        if (hipFuncSetAttribute((const void*)fwd_megakernel, hipFuncAttributeMaxDynamicSharedMemorySize, LDS_BYTES) != hipSuccess) { fprintf(stderr, "kernel_launch: hipFuncSetAttribute failed\n"); grid = -1; return; }
        if (hipOccupancyMaxActiveBlocksPerMultiprocessor(&per_cu, (const void*)fwd_megakernel, NTHREADS, LDS_BYTES) != hipSuccess || per_cu < 1) { fprintf(stderr, "kernel_launch: occupancy query says %d blocks per CU\n", per_cu); (void)hipGetLastError(); grid = -1; return; }
        grid = cus;
        if (grid != 256) { fprintf(stderr, "kernel_launch: this kernel is built for a 256-CU device (got %d)\n", cus); grid = -1; return; }
    }
    if (grid < 0) return;
    if (hipMemsetAsync((char*)d_ws + WS_CTL, 0, CTL_ZERO_BYTES, stream) != hipSuccess) return;
    Params P{};
    P.x = (const float*)d_in[0]; P.pos = (const int*)d_in[1]; P.w_in = (const float*)d_in[2]; P.b_in = (const float*)d_in[3]; P.sinks = (const float*)d_in[4];
    P.conv_w = (const float*)d_in[5]; P.w_out = (const float*)d_in[6]; P.b_out = (const float*)d_in[7]; P.ln1g = (const float*)d_in[8]; P.ln1b = (const float*)d_in[9];
    P.w_pq = (const float*)d_in[10]; P.sk1 = (const float*)d_in[11]; P.sk2 = (const float*)d_in[12]; P.ue = (const float*)d_in[13]; P.ve = (const float*)d_in[14];
    P.ln2g = (const float*)d_in[15]; P.ln2b = (const float*)d_in[16]; P.out = (float*)d_out; P.ws = (unsigned char*)d_ws;
    hipLaunchKernelGGL(fwd_megakernel, dim3(grid), dim3(NTHREADS), LDS_BYTES, stream, P);
}
```

```cpp
#include <hip/hip_runtime.h>
#include <cstdio>
#include <cstdint>
namespace pg8 {
#define PG8_LAS __attribute__((address_space(3)))
typedef unsigned short bf16_t;
typedef short bf16x8 __attribute__((ext_vector_type(8)));
typedef float f32x4 __attribute__((ext_vector_type(4)));
typedef unsigned u32x4 __attribute__((ext_vector_type(4)));
constexpr int BM = 256, BK = 64, HALF = 128, HTB = HALF * BK * 2  , STAGE_BYTES = 8 * HTB, NXCD = 8, WGM = 8;

__host__ __device__ __forceinline__ int lds_byte(int r, int c) { const int st = (r >> 4) * 2 + (c >> 5), rr = r & 15, cc = c & 31, ob = rr * 64 + cc * 2; return st * 1024 + (ob ^ (((ob >> 9) & 1) << 5)); }
__host__ __device__ __forceinline__ void stage_rc(int b, int& R, int& C) { const int st = b / 1024, sb = b % 1024, swz = sb ^ (((sb >> 9) & 1) << 5); R = (st >> 1) * 16 + swz / 64; C = (st & 1) * 32 + (swz % 64) / 2; }
__host__ __device__ __forceinline__ int perm32(int rho) { const int n = rho >> 4, i = rho & 15; return 8 * (i >> 2) + 4 * n + (i & 3); }

struct Unit { int pm, pn; };
struct Gemm { const bf16_t* A; const bf16_t* Bt; int M, N, K; };

struct StaticOrder {
    int nM, nN, nwg, G, c;
    __host__ __device__ void init(int M, int N, int G_, int c_) { nM = M / BM; nN = N / BM; nwg = nM * nN; G = G_; c = c_; }
    __host__ __device__ bool next(int i, Unit& u) const {
        const long L = (long)i * G + c; if (L >= nwg) return false;
        int wgid = (int)L; { const int q = nwg / NXCD, r = nwg % NXCD, xcd = wgid % NXCD, off = wgid / NXCD; wgid = (xcd < r ? xcd * (q + 1) : r * (q + 1) + (xcd - r) * q) + off; }
        const int nig = WGM * nN, gid = wgid / nig, fm = gid * WGM, gsz = (nM - fm) < WGM ? (nM - fm) : WGM;
        u.pm = fm + ((wgid % nig) % gsz); u.pn = (wgid % nig) / gsz; return true;
    }
    __device__ __forceinline__ void a_ready(const Unit&) const {}
    __device__ __forceinline__ void done(const Unit&) const {}
};

__device__ __forceinline__ unsigned cvt_pk_bf16(float lo, float hi) { unsigned r; asm volatile("v_cvt_pk_bf16_f32 %0, %1, %2" : "=v"(r) : "v"(lo), "v"(hi)); return r; }
typedef float f32x2 __attribute__((ext_vector_type(2)));
__device__ __forceinline__ f32x2 gelu_pk(f32x2 v) {
    const f32x2 av = __builtin_elementwise_abs(v), d = av * 0.2316418882f + 1.0f;
    f32x2 t; t.x = __builtin_amdgcn_rcpf(d.x); t.y = __builtin_amdgcn_rcpf(d.y);
    f32x2 q = t * 0.5307027145f + (-0.7265760135f); q = q * t + 0.7107068705f; q = q * t + (-0.142248368f); q = q * t + 0.127414796f; q = q * t;
    const f32x2 s = (v * v) * (-0.72134752044f);
    f32x2 e; e.x = __builtin_amdgcn_exp2f(s.x); e.y = __builtin_amdgcn_exp2f(s.y);
    const f32x2 m = v * (q * e), r = v - m;
    f32x2 o; o.x = v.x < 0.f ? m.x : r.x; o.y = v.y < 0.f ? m.y : r.y; return o;
}

template <int ACT  > struct EpiBf16 {
    static constexpr bool PERM = true, AFTER_DRAIN = false; static_assert(ACT == 0 || ACT == 1, "EpiBf16: ACT is 0 (none) or 1 (gelu_pk)");
    bf16_t* O; int ldc; const float* bias; int split_cols; size_t split_stride; float scale0;
    __device__ __forceinline__ void operator()(const f32x4 (&acc)[2][2][4][2], const Unit& u, int wr, int wc, int fr, int fq) const {
        const int row0 = u.pm * BM + wr * 64 + fr; int colt = u.pn * BM; bf16_t* base = O;
        float sc = 1.f; if (split_cols) { const int t = colt / split_cols; base += (size_t)t * split_stride; colt -= t * split_cols; if (t == 0) sc = scale0; }
        const int col0 = colt + wc * 32 + 8 * fq, bcol0 = u.pn * BM + wc * 32 + 8 * fq;
        f32x4 bv[2][2];
#pragma unroll
        for (int bj = 0; bj < 2; ++bj)
#pragma unroll
            for (int n = 0; n < 2; ++n) bv[bj][n] = bias ? *(const f32x4*)(bias + bcol0 + bj * HALF + 4 * n) : (f32x4){0.f, 0.f, 0.f, 0.f};
#pragma unroll
        for (int ai = 0; ai < 2; ++ai)
#pragma unroll
            for (int m = 0; m < 4; ++m) { bf16_t* rowp = base + (size_t)(row0 + ai * HALF + m * 16) * ldc + col0;
#pragma unroll
                for (int bj = 0; bj < 2; ++bj) { f32x4 v0 = acc[ai][bj][m][0] + bv[bj][0], v1 = acc[ai][bj][m][1] + bv[bj][1];
                    if (ACT == 1) { f32x2 a = gelu_pk((f32x2){v0[0], v0[1]}), b = gelu_pk((f32x2){v0[2], v0[3]}), c = gelu_pk((f32x2){v1[0], v1[1]}), d = gelu_pk((f32x2){v1[2], v1[3]});
                        v0 = (f32x4){a.x, a.y, b.x, b.y}; v1 = (f32x4){c.x, c.y, d.x, d.y}; }
                    v0 = v0 * sc; v1 = v1 * sc; u32x4 w; w.x = cvt_pk_bf16(v0[0], v0[1]); w.y = cvt_pk_bf16(v0[2], v0[3]); w.z = cvt_pk_bf16(v1[0], v1[1]); w.w = cvt_pk_bf16(v1[2], v1[3]);
                    *(u32x4*)(rowp + bj * HALF) = w; } }
    }
};

struct PanelStats {
    unsigned* xbuf;
    unsigned* cnt;
    unsigned* tmo;
    int ntn; float eps;
    unsigned code;
    __device__ __forceinline__ bool run(const f32x4 (&v)[2][2][4][2], const Unit& u, int wr, int wc, int fr, int fq, PG8_LAS unsigned char* lds, int wid, int lane) const {
        typedef float f32x2v __attribute__((ext_vector_type(2)));
        PG8_LAS f32x2v* P = (PG8_LAS f32x2v*)lds;
        PG8_LAS f32x2v* S = (PG8_LAS f32x2v*)(lds + 8192);
        PG8_LAS unsigned* flag = (PG8_LAS unsigned*)(lds + 8192 + 2048);
#pragma unroll
        for (int ai = 0; ai < 2; ++ai)
#pragma unroll
            for (int m = 0; m < 4; ++m) {
                float s = 0.f;
#pragma unroll
                for (int bj = 0; bj < 2; ++bj)
#pragma unroll
                    for (int n = 0; n < 2; ++n) { const f32x4 x = v[ai][bj][m][n]; s += (x[0] + x[1]) + (x[2] + x[3]); }
                s += __shfl_xor(s, 16); s += __shfl_xor(s, 32);
                const float mw = s * (1.0f / 64.0f); float q = 0.f;
#pragma unroll
                for (int bj = 0; bj < 2; ++bj)
#pragma unroll
                    for (int n = 0; n < 2; ++n) { const f32x4 d = v[ai][bj][m][n] - mw; q += (d[0] * d[0] + d[1] * d[1]) + (d[2] * d[2] + d[3] * d[3]); }
                q += __shfl_xor(q, 16); q += __shfl_xor(q, 32);
                if (fq == 0) P[(ai * HALF + wr * 64 + m * 16 + fr) * 4 + wc] = (f32x2v){mw, q};
            }
        asm volatile("s_waitcnt lgkmcnt(0)" ::: "memory"); __builtin_amdgcn_s_barrier(); asm volatile("" ::: "memory");
#if defined(BROKEN_EXCHANGE_NO_WAIT)
#warning BROKEN CONTROL BUILD: the row-statistics exchange does not wait; results are wrong by design
        if (blockIdx.x >= 64) { const long long t0_ = clock64(); while (clock64() - t0_ < 60000) __builtin_amdgcn_s_sleep(8); }
#endif
        const int row = wid * 32 + (lane & 31);
        if (lane < 32) {
            const f32x2v a = P[row * 4 + 0], b = P[row * 4 + 1], c = P[row * 4 + 2], d = P[row * 4 + 3];
            const float mt = (a.x + b.x + c.x + d.x) * 0.25f;
            const float da = a.x - mt, db = b.x - mt, dc = c.x - mt, dd = d.x - mt;
            const float m2 = (a.y + b.y) + (c.y + d.y) + 64.0f * ((da * da + db * db) + (dc * dc + dd * dd));
            unsigned long long* slot = (unsigned long long*)xbuf + ((size_t)(u.pm * BM + row) * 4 + u.pn);
            __hip_atomic_store(slot, ((unsigned long long)__float_as_uint(m2) << 32) | __float_as_uint(mt), __ATOMIC_RELAXED, __HIP_MEMORY_SCOPE_AGENT);
        }
        asm volatile("s_waitcnt vmcnt(0)" ::: "memory");
        if (lane == 0) __hip_atomic_fetch_add(cnt + 64 * u.pm, 1u, __ATOMIC_RELAXED, __HIP_MEMORY_SCOPE_AGENT);
        if (wid == 0) {
            bool dead = false; const unsigned long long t0 = __builtin_amdgcn_s_memrealtime(); const unsigned want = 8u * (unsigned)ntn;
            for (;;) {
#if defined(BROKEN_EXCHANGE_NO_WAIT)
                break;
#endif
                if ((unsigned)__builtin_amdgcn_readfirstlane(__hip_atomic_load(cnt + 64 * u.pm, __ATOMIC_RELAXED, __HIP_MEMORY_SCOPE_AGENT)) >= want) break;
                if (__builtin_amdgcn_s_memrealtime() - t0 > 2000000ull) {
                    if (lane == 0) { unsigned expect = 0u; __hip_atomic_compare_exchange_strong(tmo + 1, &expect, code | (unsigned)(u.pm & 0xff), __ATOMIC_RELAXED, __ATOMIC_RELAXED, __HIP_MEMORY_SCOPE_AGENT);
                                     __hip_atomic_store(tmo, 1u, __ATOMIC_RELAXED, __HIP_MEMORY_SCOPE_AGENT); }
                    dead = true; break; }
                __builtin_amdgcn_s_sleep(2);
            }
            __builtin_amdgcn_fence(__ATOMIC_ACQUIRE, "agent");
            if (lane == 0) flag[0] = dead ? 1u : 0u;
        }
        asm volatile("s_waitcnt vmcnt(0) lgkmcnt(0)" ::: "memory"); __builtin_amdgcn_s_barrier(); asm volatile("" ::: "memory");
        const bool bad = flag[0] != 0u;
        if (lane < 32) {
            const unsigned long long* slot = (const unsigned long long*)xbuf + (size_t)(u.pm * BM + row) * 4; float mt[4], m2[4]; float ms = 0.f;
#pragma unroll
            for (int t = 0; t < 4; ++t) { if (t < ntn) { const unsigned long long w = __hip_atomic_load(slot + t, __ATOMIC_RELAXED, __HIP_MEMORY_SCOPE_AGENT); mt[t] = __uint_as_float((unsigned)w); m2[t] = __uint_as_float((unsigned)(w >> 32)); } else { mt[t] = 0.f; m2[t] = 0.f; } ms += mt[t]; }
            const float mean = ms / (float)ntn; float q = 0.f;
#pragma unroll
            for (int t = 0; t < 4; ++t) if (t < ntn) { const float dm = mt[t] - mean; q += m2[t] + 256.0f * dm * dm; }
            S[row] = (f32x2v){mean, 1.0f / sqrtf(q / (256.0f * (float)ntn) + eps)};
        }
        asm volatile("s_waitcnt lgkmcnt(0)" ::: "memory"); __builtin_amdgcn_s_barrier(); asm volatile("" ::: "memory");
        return bad;
    }
};
struct EpiLnRes {
    static constexpr bool PERM = false, AFTER_DRAIN = true;
    const float* base; float* out; int ldc; const float* bias; PanelStats st; unsigned poison;
    __device__ __forceinline__ void fused(f32x4 (&acc)[2][2][4][2], const Unit& u, int wr, int wc, int fr, int fq, PG8_LAS unsigned char* lds, int wid, int lane) const {
        typedef float f32x2v __attribute__((ext_vector_type(2)));
        const PG8_LAS f32x2v* S = (const PG8_LAS f32x2v*)(lds + 8192);
        const int col0 = u.pn * BM + wc * 32 + 4 * fq;
#pragma unroll
        for (int bj = 0; bj < 2; ++bj)
#pragma unroll
            for (int n = 0; n < 2; ++n) { const f32x4 bv = bias ? *(const f32x4*)(bias + col0 + bj * HALF + n * 16) : (f32x4){0.f, 0.f, 0.f, 0.f};
#pragma unroll
                for (int ai = 0; ai < 2; ++ai)
#pragma unroll
                    for (int m = 0; m < 4; ++m) acc[ai][bj][m][n] += bv; }
        f32x4 pre[4][2][2];
#pragma unroll
        for (int m = 0; m < 4; ++m) { const size_t off = (size_t)(u.pm * BM + wr * 64 + m * 16 + fr) * ldc + col0;
#pragma unroll
            for (int bj = 0; bj < 2; ++bj)
#pragma unroll
                for (int n = 0; n < 2; ++n) pre[m][bj][n] = *(const f32x4*)(base + off + bj * HALF + n * 16); }
        const bool bad = st.run(acc, u, wr, wc, fr, fq, lds, wid, lane) || poison != 0u;
        const float qnan = __builtin_nanf("");
#pragma unroll
        for (int ai = 0; ai < 2; ++ai)
#pragma unroll
            for (int m = 0; m < 4; ++m) { const int r = ai * HALF + wr * 64 + m * 16 + fr; const f32x2v sr = S[r]; const size_t off = (size_t)(u.pm * BM + r) * ldc + col0;
#pragma unroll
                for (int bj = 0; bj < 2; ++bj)
#pragma unroll
                    for (int n = 0; n < 2; ++n) { const f32x4 bs = ai == 0 ? pre[m][bj][n] : *(const f32x4*)(base + off + bj * HALF + n * 16); f32x4 o = bs + (acc[ai][bj][m][n] - sr.x) * sr.y;
                        if (bad) o = (f32x4){qnan, qnan, qnan, qnan}; *(f32x4*)(out + off + bj * HALF + n * 16) = o; }
                if (m & 1) asm volatile("" ::: "memory"); }
    }
};
struct EpiLnResLn {
    static constexpr bool PERM = false, AFTER_DRAIN = true;
    const float* base; float* out; bf16_t* xn; int ldc; const float* bias; PanelStats st1, st2; unsigned poison;
    __device__ __forceinline__ void fused(f32x4 (&acc)[2][2][4][2], const Unit& u, int wr, int wc, int fr, int fq, PG8_LAS unsigned char* lds, int wid, int lane) const {
        typedef float f32x2v __attribute__((ext_vector_type(2))); typedef unsigned u32x2v __attribute__((ext_vector_type(2)));
        const PG8_LAS f32x2v* S = (const PG8_LAS f32x2v*)(lds + 8192);
        const int col0 = u.pn * BM + wc * 32 + 4 * fq;
#pragma unroll
        for (int bj = 0; bj < 2; ++bj)
#pragma unroll
            for (int n = 0; n < 2; ++n) { const f32x4 bv = bias ? *(const f32x4*)(bias + col0 + bj * HALF + n * 16) : (f32x4){0.f, 0.f, 0.f, 0.f};
#pragma unroll
                for (int ai = 0; ai < 2; ++ai)
#pragma unroll
                    for (int m = 0; m < 4; ++m) acc[ai][bj][m][n] += bv; }
        bool bad = st1.run(acc, u, wr, wc, fr, fq, lds, wid, lane) || poison != 0u;
        const float qnan = __builtin_nanf("");
#pragma unroll
        for (int ai = 0; ai < 2; ++ai)
#pragma unroll
            for (int m = 0; m < 4; ++m) { const int r = ai * HALF + wr * 64 + m * 16 + fr; const f32x2v sr = S[r]; const size_t off = (size_t)(u.pm * BM + r) * ldc + col0;
#pragma unroll
                for (int bj = 0; bj < 2; ++bj)
#pragma unroll
                    for (int n = 0; n < 2; ++n) { const f32x4 bs = *(const f32x4*)(base + off + bj * HALF + n * 16); acc[ai][bj][m][n] = bs + (acc[ai][bj][m][n] - sr.x) * sr.y; }
                asm volatile("" : "+v"(acc[ai][0][m][0]), "+v"(acc[ai][0][m][1]), "+v"(acc[ai][1][m][0]), "+v"(acc[ai][1][m][1]));
                if (m & 1) asm volatile("" ::: "memory"); }
        const bool bad1 = bad;
        bad = st2.run(acc, u, wr, wc, fr, fq, lds, wid, lane) || bad;
#pragma unroll
        for (int ai = 0; ai < 2; ++ai)
#pragma unroll
            for (int m = 0; m < 4; ++m) { const int r = ai * HALF + wr * 64 + m * 16 + fr; const f32x2v sr = S[r]; const size_t off = (size_t)(u.pm * BM + r) * ldc + col0;
#pragma unroll
                for (int bj = 0; bj < 2; ++bj)
#pragma unroll
                    for (int n = 0; n < 2; ++n) { const f32x4 x1 = acc[ai][bj][m][n]; *(f32x4*)(out + off + bj * HALF + n * 16) = bad1 ? (f32x4){qnan, qnan, qnan, qnan} : x1;
                        const f32x4 o = (x1 - sr.x) * sr.y; u32x2v w; w.x = cvt_pk_bf16(o[0], o[1]); w.y = cvt_pk_bf16(o[2], o[3]);
                        if (bad) { w.x = 0x7fc07fc0u; w.y = 0x7fc07fc0u; } *(u32x2v*)(xn + off + bj * HALF + n * 16) = w; }
                asm volatile("" ::: "memory"); }
    }
};

template <class Epi, class Sched, bool ALIGN_EPI = false, bool SP2 = false>
__device__ __forceinline__ void gemm_phase(PG8_LAS unsigned char* lds, const Gemm g, const Sched& S, const Epi& E) {
    const int tid = threadIdx.x, wid = __builtin_amdgcn_readfirstlane(tid >> 6), lane = tid & 63, wr = wid >> 2, wc = wid & 3, fr = lane & 15, fq = lane >> 4;
    const int K = g.K, nt = K / BK;
    unsigned voffA[2], voffB[2];
#pragma unroll
    for (int i = 0; i < 2; ++i) { int R, C; stage_rc(tid * 16 + i * 8192, R, C); const int Rb = Epi::PERM ? ((R & ~31) + perm32(R & 31)) : R;
        voffA[i] = (unsigned)(R * K + C) * 2u; voffB[i] = (unsigned)(Rb * K + C) * 2u; }
    const size_t kstep = (size_t)(BK * 2);
    const size_t hstep = (size_t)HALF * K * 2;
    const size_t tstep = 2 * hstep;
    const unsigned ldsw = (unsigned)wid * 1024u;
    const int aoff = lds_byte(wr * 64 + fr, fq * 8), boff = lds_byte(wc * 32 + fr, fq * 8);
#define PG8_SA(b, h) (((b) * 2 + (h)) * HTB)
#define PG8_SB(b, h) ((4 + (b) * 2 + (h)) * HTB)
#define PG8_STAGE(bufoff, gbase, voff) do { _Pragma("unroll") for (int _i = 0; _i < 2; ++_i) \
        __builtin_amdgcn_global_load_lds((const unsigned*)((const char*)(gbase) + (voff)[_i]), (PG8_LAS unsigned*)(lds + (bufoff) + ldsw + _i * 8192), 16, 0, 0); } while (0)
#define PG8_LDA(dst, b, h) do { _Pragma("unroll") for (int m = 0; m < 4; ++m) _Pragma("unroll") for (int k = 0; k < 2; ++k) dst[m][k] = *(const PG8_LAS bf16x8*)(lds + PG8_SA(b, h) + aoff + m * 2048 + k * 1024); } while (0)
#define PG8_LDB(dst, b, h) do { _Pragma("unroll") for (int n = 0; n < 2; ++n) _Pragma("unroll") for (int k = 0; k < 2; ++k) dst[n][k] = *(const PG8_LAS bf16x8*)(lds + PG8_SB(b, h) + boff + n * 2048 + k * 1024); } while (0)
#define PG8_MMA(ai, bj, At, Bt) do { __builtin_amdgcn_s_setprio(1); _Pragma("unroll") for (int m = 0; m < 4; ++m) _Pragma("unroll") for (int n = 0; n < 2; ++n) _Pragma("unroll") for (int k = 0; k < 2; ++k) \
        acc[ai][bj][m][n] = __builtin_amdgcn_mfma_f32_16x16x32_bf16(Bt[n][k], At[m][k], acc[ai][bj][m][n], 0, 0, 0); __builtin_amdgcn_s_setprio(0); } while (0)
#define PG8_WAIT_V(n) asm volatile("s_waitcnt vmcnt(" #n ")" ::: "memory")
#define PG8_WAIT_L(n) asm volatile("s_waitcnt lgkmcnt(" #n ")" ::: "memory")
#define PG8_BAR __builtin_amdgcn_s_barrier()
#define PG8_SCHED __builtin_amdgcn_sched_barrier(0)
    Unit cur, nxt; int ui = 0;
    if (!S.next(0, cur)) return;
    f32x4 acc[2][2][4][2];
#pragma unroll
    for (int a = 0; a < 2; ++a)
#pragma unroll
        for (int b = 0; b < 2; ++b)
#pragma unroll
            for (int m = 0; m < 4; ++m)
#pragma unroll
                for (int n = 0; n < 2; ++n) acc[a][b][m][n] = (f32x4){0.f, 0.f, 0.f, 0.f};
    bf16x8 At[4][2], B0[2][2], B1[2][2];
    const char* cA = (const char*)g.A + (size_t)cur.pm * tstep; const char* cB = (const char*)g.Bt + (size_t)cur.pn * tstep;
    S.a_ready(cur);
    if constexpr (SP2) {
        PG8_STAGE(PG8_SB(0, 0), cB, voffB); PG8_STAGE(PG8_SB(0, 1), cB + hstep, voffB); PG8_STAGE(PG8_SA(0, 0), cA, voffA); PG8_STAGE(PG8_SA(0, 1), cA + hstep, voffA);
        if (wr == 1) PG8_BAR;
        PG8_WAIT_V(2); PG8_BAR;
        PG8_STAGE(PG8_SB(1, 0), cB + kstep, voffB); PG8_STAGE(PG8_SA(1, 0), cA + kstep, voffA); PG8_STAGE(PG8_SB(1, 1), cB + hstep + kstep, voffB);
        PG8_WAIT_V(6); PG8_BAR;
    } else {
        PG8_STAGE(PG8_SB(0, 0), cB, voffB); PG8_STAGE(PG8_SA(0, 0), cA, voffA); PG8_STAGE(PG8_SB(0, 1), cB + hstep, voffB); PG8_STAGE(PG8_SA(0, 1), cA + hstep, voffA);
        if (wr == 1) PG8_BAR;
        PG8_WAIT_V(4); PG8_BAR;
        PG8_STAGE(PG8_SB(1, 0), cB + kstep, voffB); PG8_STAGE(PG8_SA(1, 0), cA + kstep, voffA); PG8_STAGE(PG8_SB(1, 1), cB + hstep + kstep, voffB);
        PG8_WAIT_V(6); PG8_BAR;
    }
    for (;;) {
        const bool has_next = S.next(ui + 1, nxt);
        const char* nA = has_next ? (const char*)g.A + (size_t)nxt.pm * tstep : cA; const char* nB = has_next ? (const char*)g.Bt + (size_t)nxt.pn * tstep : cB;
        for (int t = 0; t < nt; t += 2) {
            const bool last = (t == nt - 2);
            const char* a1 = cA + (size_t)(t + 1) * kstep;
            const char* a2 = last ? nA : cA + (size_t)(t + 2) * kstep; const char* b2 = last ? nB : cB + (size_t)(t + 2) * kstep;
            const char* a3 = a2 + kstep; const char* b3 = b2 + kstep;
            if (last && has_next) S.a_ready(nxt);
            if constexpr (SP2) {
            PG8_LDB(B0, 0, 0); PG8_LDB(B1, 0, 1); PG8_SCHED; PG8_LDA(At, 0, 0); PG8_STAGE(PG8_SA(1, 1), a1 + hstep, voffA);
            PG8_WAIT_V(8); PG8_WAIT_L(0); PG8_BAR; PG8_MMA(0, 0, At, B0); PG8_MMA(0, 1, At, B1); PG8_BAR; PG8_SCHED;
            PG8_LDA(At, 0, 1); PG8_STAGE(PG8_SB(0, 0), b2, voffB); PG8_STAGE(PG8_SB(0, 1), b2 + hstep, voffB); PG8_STAGE(PG8_SA(0, 0), a2, voffA);
            PG8_WAIT_V(8); PG8_WAIT_L(0); PG8_BAR; PG8_MMA(1, 0, At, B0); PG8_MMA(1, 1, At, B1); PG8_BAR; PG8_SCHED;
            PG8_LDB(B0, 1, 0); PG8_LDB(B1, 1, 1); PG8_SCHED; PG8_LDA(At, 1, 0); PG8_STAGE(PG8_SA(0, 1), a2 + hstep, voffA);
            PG8_WAIT_V(8); PG8_WAIT_L(0); PG8_BAR; PG8_MMA(0, 0, At, B0); PG8_MMA(0, 1, At, B1); PG8_BAR; PG8_SCHED;
            PG8_LDA(At, 1, 1); PG8_STAGE(PG8_SB(1, 0), b3, voffB); PG8_STAGE(PG8_SB(1, 1), b3 + hstep, voffB); PG8_STAGE(PG8_SA(1, 0), a3, voffA);
            PG8_WAIT_V(8); PG8_WAIT_L(0); PG8_BAR; PG8_MMA(1, 0, At, B0); PG8_MMA(1, 1, At, B1); PG8_BAR; PG8_SCHED;
            } else {
            PG8_LDB(B0, 0, 0); PG8_SCHED; PG8_LDA(At, 0, 0); PG8_STAGE(PG8_SA(1, 1), a1 + hstep, voffA);
            PG8_WAIT_L(8); PG8_BAR; PG8_WAIT_L(0); PG8_MMA(0, 0, At, B0); PG8_BAR; PG8_SCHED;
            PG8_LDB(B1, 0, 1); PG8_STAGE(PG8_SB(0, 0), b2, voffB);
            PG8_BAR; PG8_WAIT_L(0); PG8_MMA(0, 1, At, B1); PG8_BAR;
            PG8_LDA(At, 0, 1); PG8_STAGE(PG8_SA(0, 0), a2, voffA);
            PG8_BAR; PG8_WAIT_L(0); PG8_MMA(1, 0, At, B0); PG8_BAR; PG8_SCHED;
            PG8_STAGE(PG8_SB(0, 1), b2 + hstep, voffB);
            PG8_WAIT_V(6); PG8_BAR; PG8_MMA(1, 1, At, B1); PG8_BAR;
            PG8_LDB(B0, 1, 0); PG8_SCHED; PG8_LDA(At, 1, 0); PG8_STAGE(PG8_SA(0, 1), a2 + hstep, voffA);
            PG8_WAIT_L(8); PG8_BAR; PG8_WAIT_L(0); PG8_MMA(0, 0, At, B0); PG8_BAR; PG8_SCHED;
            PG8_LDB(B1, 1, 1); PG8_STAGE(PG8_SB(1, 0), b3, voffB);
            PG8_BAR; PG8_WAIT_L(0); PG8_MMA(0, 1, At, B1); PG8_BAR;
            PG8_LDA(At, 1, 1); PG8_STAGE(PG8_SA(1, 0), a3, voffA);
            PG8_BAR; PG8_WAIT_L(0); PG8_MMA(1, 0, At, B0); PG8_BAR; PG8_SCHED;
            PG8_STAGE(PG8_SB(1, 1), b3 + hstep, voffB);
            PG8_WAIT_V(6); PG8_BAR; PG8_MMA(1, 1, At, B1); PG8_BAR;
            }
        }
        if constexpr (ALIGN_EPI) { if (wr == 0) PG8_BAR; }
        if constexpr (!Epi::AFTER_DRAIN) { E(acc, cur, wr, wc, fr, fq); S.done(cur); }
        if (!has_next) break;
#pragma unroll
        for (int a = 0; a < 2; ++a)
#pragma unroll
            for (int b = 0; b < 2; ++b)
#pragma unroll
                for (int m = 0; m < 4; ++m)
#pragma unroll
                    for (int n = 0; n < 2; ++n) acc[a][b][m][n] = (f32x4){0.f, 0.f, 0.f, 0.f};
        cur = nxt; cA = nA; cB = nB; ++ui;
        if constexpr (ALIGN_EPI) { if (wr == 1) PG8_BAR; }
    }
    PG8_WAIT_V(0);
    if constexpr (!ALIGN_EPI) { if (wr == 0) PG8_BAR; }
    PG8_BAR;
    if constexpr (Epi::AFTER_DRAIN) { E.fused(acc, cur, wr, wc, fr, fq, lds, wid, lane); S.done(cur); }
#undef PG8_SA
#undef PG8_SB
#undef PG8_STAGE
#undef PG8_LDA
#undef PG8_LDB
#undef PG8_MMA
#undef PG8_WAIT_V
#undef PG8_WAIT_L
#undef PG8_BAR
#undef PG8_SCHED
}
}

#define LAS __attribute__((address_space(3)))
typedef unsigned short bf16;
typedef float f32x4 __attribute__((ext_vector_type(4)));
typedef float f32x16 __attribute__((ext_vector_type(16)));
typedef unsigned u32x4 __attribute__((ext_vector_type(4)));
typedef unsigned u32x2 __attribute__((ext_vector_type(2)));
typedef short bf16x8 __attribute__((ext_vector_type(8)));
typedef float f32x2 __attribute__((ext_vector_type(2)));

constexpr int NTOK = 16384, DM = 1024, SEQ = 8192, NPROJ = 2304, NPQ = 2048, NEXP = 16384;
constexpr float DN_ALPHA = 1.189207115002721f;
constexpr float LN_EPS = 1e-5f;
constexpr float LOG2E = 1.4426950408889634f;
constexpr int NWAVES = 8, NTHREADS = 512;
constexpr int LDS_BYTES = 163840;

constexpr size_t MiB = 1u << 20;
constexpr size_t WS_CTL = 0, WS_WIN = 1 * MiB, WS_WOUT = 6 * MiB, WS_WPQ = 8 * MiB, WS_CS = 12 * MiB;
constexpr size_t WS_UB = 16 * MiB, WS_VB = 48 * MiB, WS_XB = 80 * MiB, WS_Y = 80 * MiB;
constexpr size_t WS_UB8 = 16 * MiB, WS_VB8 = 32 * MiB, WS_ISU = 14 * MiB, WS_ISV = 15 * MiB;
constexpr size_t WS_PROJ = 112 * MiB, WS_H1F = 112 * MiB, WS_H1B = 184 * MiB, WS_EIDX = 216 * MiB, WS_GATE = 224 * MiB, WS_END = 232 * MiB;

struct Params {
    const float* x; const int* pos; const float* w_in; const float* b_in; const float* sinks; const float* conv_w; const float* w_out; const float* b_out;
    const float* ln1g; const float* ln1b; const float* w_pq; const float* sk1; const float* sk2; const float* ue; const float* ve; const float* ln2g; const float* ln2b;
    float* out; unsigned char* ws;
};

__device__ __forceinline__ unsigned f2bf(float f) { unsigned u = __builtin_bit_cast(unsigned, f); return (u + 0x7fffu + ((u >> 16) & 1u)) >> 16; }
__device__ __forceinline__ unsigned pk2(float lo, float hi) { return f2bf(lo) | (f2bf(hi) << 16); }
__device__ __forceinline__ float bf_lo(unsigned w) { return __builtin_bit_cast(float, w << 16); }
__device__ __forceinline__ float bf_hi(unsigned w) { return __builtin_bit_cast(float, w & 0xffff0000u); }
__device__ __forceinline__ float wave_sum(float v) {
#pragma unroll
    for (int o = 1; o < 64; o <<= 1) v += __shfl_xor(v, o);
    return v;
}

__constant__ double ROPE_INVF[8] = {1.0, 0.19392274474868576, 0.03760603093086393, 0.007292664737217109, 0.001414213562373095, 0.0002742481756762073, 5.318295896944988e-05, 1.031338537721246e-05};

namespace pg8 {
struct EpiProj {
    static constexpr bool PERM = true, AFTER_DRAIN = false;
    bf16_t* O; const float* bias; const float* cs;
    __device__ __forceinline__ void operator()(const f32x4 (&acc)[2][2][4][2], const Unit& u, int wr, int wc, int fr, int fq) const {
        const int row0 = u.pm * BM + wr * 64 + fr;
        const int col0 = u.pn * BM + wc * 32 + 8 * fq;
        f32x4 bv[2][2];
#pragma unroll
        for (int bj = 0; bj < 2; ++bj)
#pragma unroll
            for (int n = 0; n < 2; ++n) bv[bj][n] = *(const f32x4*)(bias + col0 + bj * HALF + 4 * n);
        const bool rope_wave = (u.pn <= 2) && ((wc & 1) == 0);
#pragma unroll
        for (int ai = 0; ai < 2; ++ai)
#pragma unroll
            for (int m = 0; m < 4; ++m) {
                const int row = row0 + ai * HALF + m * 16;
                bf16_t* rowp = O + (size_t)row * 2304 + col0;
                f32x4 c0 = {1.f, 0.f, 1.f, 0.f}, c1 = c0, c2 = c0, c3 = c0;
                if (rope_wave && fq < 2) { const f32x4* cp = (const f32x4*)(cs + (size_t)row * 16); c0 = cp[0]; c1 = cp[1]; c2 = cp[2]; c3 = cp[3]; }
#pragma unroll
                for (int bj = 0; bj < 2; ++bj) {
                    f32x4 v0 = acc[ai][bj][m][0] + bv[bj][0], v1 = acc[ai][bj][m][1] + bv[bj][1];
                    if (rope_wave && (u.pn < 2 || bj == 0)) {
                        f32x4 p0, p1;
#pragma unroll
                        for (int e = 0; e < 4; ++e) { p0[e] = __shfl_xor(v0[e], 16); p1[e] = __shfl_xor(v1[e], 16); }
                        if (fq < 2) {
                            const float sg = (fq == 0) ? -1.f : 1.f;
                            v0[0] = v0[0] * c0[0] + sg * p0[0] * c0[1]; v0[1] = v0[1] * c0[2] + sg * p0[1] * c0[3];
                            v0[2] = v0[2] * c1[0] + sg * p0[2] * c1[1]; v0[3] = v0[3] * c1[2] + sg * p0[3] * c1[3];
                            v1[0] = v1[0] * c2[0] + sg * p1[0] * c2[1]; v1[1] = v1[1] * c2[2] + sg * p1[1] * c2[3];
                            v1[2] = v1[2] * c3[0] + sg * p1[2] * c3[1]; v1[3] = v1[3] * c3[2] + sg * p1[3] * c3[3];
                        }
                    }
                    u32x4 w; w.x = cvt_pk_bf16(v0[0], v0[1]); w.y = cvt_pk_bf16(v0[2], v0[3]); w.z = cvt_pk_bf16(v1[0], v1[1]); w.w = cvt_pk_bf16(v1[2], v1[3]);
                    *(u32x4*)(rowp + bj * HALF) = w;
                }
            }
    }
};
struct EpiF32 {
    static constexpr bool PERM = false, AFTER_DRAIN = false;
    float* O; int ldc; const float* bias;
    __device__ __forceinline__ void operator()(const f32x4 (&acc)[2][2][4][2], const Unit& u, int wr, int wc, int fr, int fq) const {
        const int row0 = u.pm * BM + wr * 64 + fr;
        const int col0 = u.pn * BM + wc * 32 + 4 * fq;
#pragma unroll
        for (int bj = 0; bj < 2; ++bj)
#pragma unroll
            for (int n = 0; n < 2; ++n) {
                const f32x4 bv = *(const f32x4*)(bias + col0 + bj * HALF + n * 16);
#pragma unroll
                for (int ai = 0; ai < 2; ++ai)
#pragma unroll
                    for (int m = 0; m < 4; ++m) *(f32x4*)(O + (size_t)(row0 + ai * HALF + m * 16) * ldc + col0 + bj * HALF + n * 16) = acc[ai][bj][m][n] + bv;
            }
    }
};
}

__device__ __forceinline__ void p0_transpose_item(const float* W, int K, int N, bf16* WT, LAS float* scr, int item, int lane) {
    const int nblk = N / 32, kb = item / nblk, nb = item % nblk, k0 = 64 * kb, n0 = 32 * nb;
#pragma unroll 8
    for (int i = 0; i < 32; ++i) { const int kk = 2 * i + (lane >> 5); scr[kk * 33 + (lane & 31)] = W[(size_t)(k0 + kk) * N + n0 + (lane & 31)]; }
    asm volatile("s_waitcnt lgkmcnt(0)" ::: "memory");
    const int c = lane & 7;
#pragma unroll
    for (int j = 0; j < 4; ++j) { const int n = (lane >> 3) + 8 * j; const LAS float* s = scr + (8 * c) * 33 + n;
        u32x4 o; o.x = pk2(s[0 * 33], s[1 * 33]); o.y = pk2(s[2 * 33], s[3 * 33]); o.z = pk2(s[4 * 33], s[5 * 33]); o.w = pk2(s[6 * 33], s[7 * 33]);
        *(u32x4*)(WT + (size_t)(n0 + n) * K + k0 + 8 * c) = o; }
    asm volatile("s_waitcnt lgkmcnt(0)" ::: "memory");
}
__device__ __forceinline__ void row_to_bf16(const float* src, bf16* dst, int lane) {
    const f32x4* s = (const f32x4*)src + lane; unsigned long long* o = (unsigned long long*)dst + lane;
#pragma unroll
    for (int j = 0; j < 4; ++j) { const f32x4 v = s[64 * j]; o[64 * j] = (unsigned long long)pk2(v.x, v.y) | ((unsigned long long)pk2(v.z, v.w) << 32); }
}
__device__ __forceinline__ void phase_prologue(const Params& P, LAS unsigned char* lds) {
    const int tid = threadIdx.x, lane = tid & 63, wave = __builtin_amdgcn_readfirstlane(tid >> 6);
    const int gw = blockIdx.x * NWAVES + wave, NGW = gridDim.x * NWAVES;
    LAS float* scr = (LAS float*)(lds + wave * 16384);
    constexpr int I_IN = 16 * (NPROJ / 32), I_OUT = 16 * (DM / 32), I_PQ = 16 * (NPQ / 32);
    for (int it = gw; it < I_IN + I_OUT + I_PQ; it += NGW) {
        int r = it;
        if (r < I_IN) { p0_transpose_item(P.w_in, DM, NPROJ, (bf16*)(P.ws + WS_WIN), scr, r, lane); continue; } r -= I_IN;
        if (r < I_OUT) { p0_transpose_item(P.w_out, DM, DM, (bf16*)(P.ws + WS_WOUT), scr, r, lane); continue; } r -= I_OUT;
        p0_transpose_item(P.w_pq, DM, NPQ, (bf16*)(P.ws + WS_WPQ), scr, r, lane);
    }
    for (int m = gw; m < NTOK; m += NGW) row_to_bf16(P.x + (size_t)m * DM, (bf16*)(P.ws + WS_XB) + (size_t)m * DM, lane);
    for (int m = gw; m < 2 * NEXP; m += NGW) {
        const int which = m >> 14, r = m & 16383;
        const f32x4* sp = (const f32x4*)((which ? P.ve : P.ue) + (size_t)r * DM + 16 * lane);
        f32x4 v[4]; float mx = 0.f;
#pragma unroll
        for (int q = 0; q < 4; ++q) { v[q] = sp[q]; mx = fmaxf(mx, fmaxf(fmaxf(fabsf(v[q].x), fabsf(v[q].y)), fmaxf(fabsf(v[q].z), fabsf(v[q].w)))); }
#pragma unroll
        for (int o = 1; o < 64; o <<= 1) mx = fmaxf(mx, __shfl_xor(mx, o));
        const float sc = mx > 0.f ? __uint_as_float(__float_as_uint(256.f / mx) & 0x7f800000u) : 1.f, inv = 1.f / sc;
        u32x4 w;
#pragma unroll
        for (int q = 0; q < 4; ++q) { int p = __builtin_amdgcn_cvt_pk_fp8_f32(v[q].x * sc, v[q].y * sc, 0, false); p = __builtin_amdgcn_cvt_pk_fp8_f32(v[q].z * sc, v[q].w * sc, p, true); w[q] = (unsigned)p; }
        *(u32x4*)(P.ws + (which ? WS_VB8 : WS_UB8) + (size_t)r * 1024 + 16 * lane) = w;
        if (lane == 0) ((float*)(P.ws + (which ? WS_ISV : WS_ISU)))[r] = inv;
    }
    float* cs = (float*)(P.ws + WS_CS);
    for (int e = blockIdx.x * NTHREADS + tid; e < NTOK * 8; e += gridDim.x * NTHREADS) {
        const int t = e >> 3, i = e & 7;
        const double ang = (double)P.pos[t] * ROPE_INVF[i];
        double sn, cn; sincos(ang, &sn, &cn);
        cs[2 * e] = (float)cn; cs[2 * e + 1] = (float)sn;
    }
}

__device__ __forceinline__ void phase_attn(const Params& P, LAS unsigned char* lds) {
    const int tid = threadIdx.x, lane = tid & 63, wave = __builtin_amdgcn_readfirstlane(tid >> 6), r = lane & 31, h = lane >> 5;
    const bf16* proj = (const bf16*)(P.ws + WS_PROJ); bf16* y = (bf16*)(P.ws + WS_Y);
    LAS unsigned char* Kl = lds;
    LAS unsigned char* Vt = lds + 36864;
    for (int unit = blockIdx.x; unit < 256; unit += gridDim.x) {
        const int b = unit >> 7, n = (unit >> 1) & 63, hk = unit & 1;
        const int tok0 = b * SEQ + n * 128;
        __syncthreads();
#pragma unroll
        for (int i = 0; i < 4; ++i) {
            const int row = (tid >> 3) + 64 * i, ch = tid & 7;
            const bool valid = (n > 0) || (row >= 128);
            u32x4 kv = {0u, 0u, 0u, 0u}, vv = {0u, 0u, 0u, 0u};
            if (valid) { const bf16* src = proj + (size_t)(tok0 - 128 + row) * NPROJ + 512 + hk * 64 + ch * 8; kv = *(const u32x4*)src; vv = *(const u32x4*)(src + 128); }
            *(LAS u32x4*)(Kl + row * 144 + ch * 16) = kv;
            LAS unsigned short* vt = (LAS unsigned short*)(Vt + (ch * 8) * 520 + row * 2);
            vt[0 * 260] = (unsigned short)(vv.x & 0xffffu); vt[1 * 260] = (unsigned short)(vv.x >> 16);
            vt[2 * 260] = (unsigned short)(vv.y & 0xffffu); vt[3 * 260] = (unsigned short)(vv.y >> 16);
            vt[4 * 260] = (unsigned short)(vv.z & 0xffffu); vt[5 * 260] = (unsigned short)(vv.z >> 16);
            vt[6 * 260] = (unsigned short)(vv.w & 0xffffu); vt[7 * 260] = (unsigned short)(vv.w >> 16);
        }
        __syncthreads();
        const int g = wave >> 1, qh = wave & 1, head = hk * 4 + g;
        const float sink = P.sinks[head];
#pragma unroll 1
        for (int blk = 0; blk < 2; ++blk) {
            const int qb = 2 * qh + blk, q0 = 32 * qb;
            const bf16* qp = proj + (size_t)(tok0 + q0 + r) * NPROJ + head * 64 + 8 * h;
            bf16x8 qf[4];
#pragma unroll
            for (int s = 0; s < 4; ++s) qf[s] = *(const bf16x8*)(qp + 16 * s);
            f32x16 st[5];
#pragma unroll
            for (int kt5 = 0; kt5 < 5; ++kt5) {
                f32x16 acc;
#pragma unroll
                for (int i = 0; i < 16; ++i) acc[i] = 0.f;
                const LAS unsigned char* kp = Kl + ((qb + kt5) * 32 + r) * 144 + 16 * h;
#pragma unroll
                for (int s = 0; s < 4; ++s) { const bf16x8 a = *(const LAS bf16x8*)(kp + 32 * s); acc = __builtin_amdgcn_mfma_f32_32x32x16_bf16(a, qf[s], acc, 0, 0, 0); }
                st[kt5] = acc;
            }
            float mx = -INFINITY;
#pragma unroll
            for (int kt5 = 0; kt5 < 5; ++kt5)
#pragma unroll
                for (int i = 0; i < 16; ++i) {
                    const int keyrow = (i & 3) + 8 * (i >> 2) + 4 * h;
                    const int kj = (qb + kt5) * 32 + keyrow, rel = 32 * kt5 + keyrow - r;
                    const bool valid = (rel >= 1) && (rel <= 128) && (n > 0 || kj >= 128);
                    const float v = valid ? st[kt5][i] * 0.125f : -INFINITY;
                    st[kt5][i] = v; mx = fmaxf(mx, v);
                }
            mx = fmaxf(mx, __shfl_xor(mx, 32)); mx = fmaxf(mx, sink);
            float l = 0.f;
#pragma unroll
            for (int kt5 = 0; kt5 < 5; ++kt5)
#pragma unroll
                for (int i = 0; i < 16; ++i) { const float p = exp2f((st[kt5][i] - mx) * LOG2E); st[kt5][i] = p; l += p; }
            l += __shfl_xor(l, 32); l += exp2f((sink - mx) * LOG2E);
            f32x16 ot[2];
#pragma unroll
            for (int i = 0; i < 16; ++i) { ot[0][i] = 0.f; ot[1][i] = 0.f; }
#pragma unroll
            for (int kt5 = 0; kt5 < 5; ++kt5)
#pragma unroll
                for (int s2 = 0; s2 < 2; ++s2) {
                    u32x4 w; w.x = pk2(st[kt5][8 * s2 + 0], st[kt5][8 * s2 + 1]); w.y = pk2(st[kt5][8 * s2 + 2], st[kt5][8 * s2 + 3]);
                    w.z = pk2(st[kt5][8 * s2 + 4], st[kt5][8 * s2 + 5]); w.w = pk2(st[kt5][8 * s2 + 6], st[kt5][8 * s2 + 7]);
                    const bf16x8 pb = __builtin_bit_cast(bf16x8, w);
                    const int base = (qb + kt5) * 32 + 16 * s2 + 4 * h;
#pragma unroll
                    for (int dblk = 0; dblk < 2; ++dblk) {
                        const LAS unsigned char* vp = Vt + (32 * dblk + r) * 520 + base * 2;
                        const u32x2 lo = *(const LAS u32x2*)vp, hi = *(const LAS u32x2*)(vp + 16);
                        u32x4 aw; aw.x = lo.x; aw.y = lo.y; aw.z = hi.x; aw.w = hi.y;
                        ot[dblk] = __builtin_amdgcn_mfma_f32_32x32x16_bf16(__builtin_bit_cast(bf16x8, aw), pb, ot[dblk], 0, 0, 0);
                    }
                }
            const float inv = 1.f / l;
            bf16* yp = y + (size_t)(tok0 + q0 + r) * DM + head * 64;
#pragma unroll
            for (int dblk = 0; dblk < 2; ++dblk)
#pragma unroll
                for (int g4 = 0; g4 < 4; ++g4) {
                    u32x2 o; o.x = pk2(ot[dblk][4 * g4] * inv, ot[dblk][4 * g4 + 1] * inv); o.y = pk2(ot[dblk][4 * g4 + 2] * inv, ot[dblk][4 * g4 + 3] * inv);
                    *(u32x2*)(yp + 32 * dblk + 8 * g4 + 4 * h) = o;
                }
        }
        {
            const int cc = tid & 31, tg = tid >> 5, c0 = 256 * hk + 8 * cc;
            float w0[8], w1[8], w2[8], p1[8], p2[8];
#pragma unroll
            for (int e = 0; e < 8; ++e) { w0[e] = P.conv_w[c0 + e]; w1[e] = P.conv_w[512 + c0 + e]; w2[e] = P.conv_w[1024 + c0 + e]; p1[e] = 0.f; p2[e] = 0.f; }
            const int tl0 = 128 * n + 8 * tg;
#pragma unroll
            for (int k = 2; k >= 1; --k) {
                const int tloc = tl0 - k;
                if (tloc >= 0) {
                    const bf16* src = proj + (size_t)(b * SEQ + tloc) * NPROJ + c0;
                    const u32x4 gc = *(const u32x4*)(src + 1280), xc = *(const u32x4*)(src + 1792);
                    float pv[8];
                    pv[0] = bf_lo(gc.x) * bf_lo(xc.x); pv[1] = bf_hi(gc.x) * bf_hi(xc.x); pv[2] = bf_lo(gc.y) * bf_lo(xc.y); pv[3] = bf_hi(gc.y) * bf_hi(xc.y);
                    pv[4] = bf_lo(gc.z) * bf_lo(xc.z); pv[5] = bf_hi(gc.z) * bf_hi(xc.z); pv[6] = bf_lo(gc.w) * bf_lo(xc.w); pv[7] = bf_hi(gc.w) * bf_hi(xc.w);
#pragma unroll
                    for (int e = 0; e < 8; ++e) { if (k == 2) p2[e] = pv[e]; else p1[e] = pv[e]; }
                }
            }
#pragma unroll 2
            for (int j = 0; j < 8; ++j) {
                const size_t row = (size_t)(b * SEQ + tl0 + j);
                const bf16* src = proj + row * NPROJ + c0;
                const u32x4 gb = *(const u32x4*)(src + 768), gc = *(const u32x4*)(src + 1280), xc = *(const u32x4*)(src + 1792);
                float p0[8], gbf[8], o[8];
                p0[0] = bf_lo(gc.x) * bf_lo(xc.x); p0[1] = bf_hi(gc.x) * bf_hi(xc.x); p0[2] = bf_lo(gc.y) * bf_lo(xc.y); p0[3] = bf_hi(gc.y) * bf_hi(xc.y);
                p0[4] = bf_lo(gc.z) * bf_lo(xc.z); p0[5] = bf_hi(gc.z) * bf_hi(xc.z); p0[6] = bf_lo(gc.w) * bf_lo(xc.w); p0[7] = bf_hi(gc.w) * bf_hi(xc.w);
                gbf[0] = bf_lo(gb.x); gbf[1] = bf_hi(gb.x); gbf[2] = bf_lo(gb.y); gbf[3] = bf_hi(gb.y); gbf[4] = bf_lo(gb.z); gbf[5] = bf_hi(gb.z); gbf[6] = bf_lo(gb.w); gbf[7] = bf_hi(gb.w);
#pragma unroll
                for (int e = 0; e < 8; ++e) { o[e] = gbf[e] * (w0[e] * p2[e] + w1[e] * p1[e] + w2[e] * p0[e]); p2[e] = p1[e]; p1[e] = p0[e]; }
                u32x4 ow; ow.x = pk2(o[0], o[1]); ow.y = pk2(o[2], o[3]); ow.z = pk2(o[4], o[5]); ow.w = pk2(o[6], o[7]);
                *(u32x4*)(y + row * DM + 512 + c0) = ow;
            }
        }
    }
}

__device__ __forceinline__ void phase_ln1(const Params& P, const float* mix) {
    const int tid = threadIdx.x, lane = tid & 63, wave = __builtin_amdgcn_readfirstlane(tid >> 6);
    const int gw = blockIdx.x * NWAVES + wave, NGW = gridDim.x * NWAVES;
    float* h1f = (float*)(P.ws + WS_H1F); bf16* h1b = (bf16*)(P.ws + WS_H1B);
    f32x4 gg[4], bb[4];
#pragma unroll
    for (int j = 0; j < 4; ++j) { gg[j] = ((const f32x4*)P.ln1g)[lane + 64 * j]; bb[j] = ((const f32x4*)P.ln1b)[lane + 64 * j]; }
    for (int m = gw; m < NTOK; m += NGW) {
        const f32x4* xr = (const f32x4*)(P.x + (size_t)m * DM) + lane; const f32x4* mr = (const f32x4*)(mix + (size_t)m * DM) + lane;
        f32x4 v[4]; float s = 0.f;
#pragma unroll
        for (int j = 0; j < 4; ++j) { v[j] = xr[64 * j] * DN_ALPHA + mr[64 * j]; s += (v[j].x + v[j].y) + (v[j].z + v[j].w); }
        const float mean = wave_sum(s) * (1.f / DM); float s2 = 0.f;
#pragma unroll
        for (int j = 0; j < 4; ++j) { v[j] = v[j] - mean; s2 += (v[j].x * v[j].x + v[j].y * v[j].y) + (v[j].z * v[j].z + v[j].w * v[j].w); }
        const float rstd = 1.f / sqrtf(wave_sum(s2) * (1.f / DM) + LN_EPS);
        f32x4* of = (f32x4*)(h1f + (size_t)m * DM) + lane; unsigned long long* ob = (unsigned long long*)(h1b + (size_t)m * DM) + lane;
#pragma unroll
        for (int j = 0; j < 4; ++j) { const f32x4 o = v[j] * rstd * gg[j] + bb[j]; of[64 * j] = o; ob[64 * j] = (unsigned long long)pk2(o.x, o.y) | ((unsigned long long)pk2(o.z, o.w) << 32); }
    }
}

__device__ __forceinline__ int tokey(float f) { const int u = __builtin_bit_cast(int, f); return u ^ ((u >> 31) & 0x7fffffff); }
__device__ __forceinline__ float fromkey(int k) { const int u = k ^ ((k >> 31) & 0x7fffffff); return __builtin_bit_cast(float, u); }
#define CSWAP_DESC(a, b) do { const int _x = (a), _y = (b); (a) = _x > _y ? _x : _y; (b) = _x > _y ? _y : _x; } while (0)
__device__ __forceinline__ void sort16_desc(int (&v)[16]) {
#pragma unroll
    for (int k = 2; k <= 16; k <<= 1)
#pragma unroll
        for (int j = k >> 1; j > 0; j >>= 1)
#pragma unroll
            for (int i = 0; i < 16; ++i) { const int l = i ^ j; if (l > i) { if ((i & k) == 0) CSWAP_DESC(v[i], v[l]); else CSWAP_DESC(v[l], v[i]); } }
}
__device__ __forceinline__ void merge16(int (&a)[16], const int (&b)[16]) {
#pragma unroll
    for (int i = 0; i < 16; ++i) a[i] = a[i] > b[15 - i] ? a[i] : b[15 - i];
#pragma unroll
    for (int j = 8; j > 0; j >>= 1)
#pragma unroll
        for (int i = 0; i < 16; ++i) { const int l = i ^ j; if (l > i) CSWAP_DESC(a[i], a[l]); }
}
__device__ __forceinline__ void top16_of_64(const int (&k)[64], int (&out)[16]) {
    int g1[16], g2[16], g3[16];
#pragma unroll
    for (int i = 0; i < 16; ++i) { out[i] = k[i]; g1[i] = k[16 + i]; g2[i] = k[32 + i]; g3[i] = k[48 + i]; }
    sort16_desc(out); sort16_desc(g1); sort16_desc(g2); sort16_desc(g3);
    merge16(out, g1); merge16(g2, g3); merge16(out, g2);
}
struct CandTab { int ci[64]; int cj[64]; int n; };
constexpr CandTab make_cand() { CandTab t{}; int n = 0; for (int i = 0; i < 16; ++i) for (int j = 0; j < 16; ++j) if ((i + 1) * (j + 1) <= 16) { t.ci[n] = i; t.cj[n] = j; ++n; } t.n = n; return t; }
constexpr CandTab CT = make_cand();
static_assert(CT.n == 50, "staircase candidates");

constexpr int TK_SKP = 272;
constexpr int TK_SK2 = 128 * TK_SKP, TK_SCR = 2 * 128 * TK_SKP;

__device__ __forceinline__ void phase_topk(const Params& P, LAS unsigned char* lds, const bf16* qpeer) {
    const int tid = threadIdx.x, lane = tid & 63, wave = __builtin_amdgcn_readfirstlane(tid >> 6), r = lane & 31, h = lane >> 5;
    int* eidx = (int*)(P.ws + WS_EIDX); float* gate = (float*)(P.ws + WS_GATE);
    __syncthreads();
    for (int e = tid; e < 2 * 128 * 32; e += NTHREADS) {
        const int which = e >> 12, rem = e & 4095, row = rem >> 5, c4 = rem & 31;
        const f32x4 v = *(const f32x4*)((which ? P.sk2 : P.sk1) + row * 128 + c4 * 4);
        u32x2 w; w.x = pk2(v.x, v.y); w.y = pk2(v.z, v.w);
        *(LAS u32x2*)(lds + which * TK_SK2 + row * TK_SKP + c4 * 8) = w;
    }
    __syncthreads();
    LAS int* scr = (LAS int*)(lds + TK_SCR + wave * 8192);
    for (int task = blockIdx.x * NWAVES + wave; task < 2048; task += gridDim.x * NWAVES) {
        const int tb = task >> 2, hp = task & 3;
        int L[2][2][16];
#pragma unroll
        for (int hh = 0; hh < 2; ++hh)
#pragma unroll
            for (int half = 0; half < 2; ++half) {
                const int head = 2 * hp + hh;
                asm volatile("" ::: "memory"); __builtin_amdgcn_sched_barrier(0);
                const bf16* qp = qpeer + (size_t)(32 * tb + r) * NPQ + 256 * head + 128 * half + 8 * h;
                bf16x8 qf[8];
#pragma unroll
                for (int s = 0; s < 8; ++s) qf[s] = *(const bf16x8*)(qp + 16 * s);
#pragma unroll
                for (int kt = 0; kt < 4; ++kt) {
                    __builtin_amdgcn_sched_barrier(0);
                    f32x16 acc;
#pragma unroll
                    for (int i = 0; i < 16; ++i) acc[i] = 0.f;
                    const LAS unsigned char* kp = lds + half * TK_SK2 + (kt * 32 + r) * TK_SKP + 16 * h;
#pragma unroll
                    for (int s = 0; s < 8; ++s) { const bf16x8 a = *(const LAS bf16x8*)(kp + 32 * s); acc = __builtin_amdgcn_mfma_f32_32x32x16_bf16(a, qf[s], acc, 0, 0, 0); }
                    int tk[16];
#pragma unroll
                    for (int i = 0; i < 16; ++i) { const int idx = kt * 32 + (i & 3) + 8 * (i >> 2) + 4 * h; tk[i] = (tokey(acc[i]) & ~127) | idx; }
                    sort16_desc(tk);
                    if (kt == 0) {
#pragma unroll
                        for (int i = 0; i < 16; ++i) L[hh][half][i] = tk[i];
                    } else merge16(L[hh][half], tk);
                }
            }
        int a[16], b[16];
#pragma unroll
        for (int half = 0; half < 2; ++half) {
            int own[16], oth[16];
#pragma unroll
            for (int i = 0; i < 16; ++i) {
                const int send = h ? L[0][half][i] : L[1][half][i];
                own[i] = h ? L[1][half][i] : L[0][half][i];
                oth[i] = __shfl_xor(send, 32);
            }
            merge16(own, oth);
#pragma unroll
            for (int i = 0; i < 16; ++i) { if (half == 0) a[i] = own[i]; else b[i] = own[i]; }
        }
        float fa[16], fb[16];
#pragma unroll
        for (int i = 0; i < 16; ++i) { fa[i] = fromkey(a[i] & ~127); fb[i] = fromkey(b[i] & ~127); scr[i * 64 + lane] = a[i] & 127; scr[(16 + i) * 64 + lane] = b[i] & 127; }
        int top[16];
#pragma unroll
        for (int gq = 0; gq < 4; ++gq) {
            __builtin_amdgcn_sched_barrier(0);
            int ck[16];
#pragma unroll
            for (int s2 = 0; s2 < 16; ++s2) {
                const int s = gq * 16 + s2;
                if (s < CT.n) ck[s2] = (tokey(fa[CT.ci[s]] + fb[CT.cj[s]]) & ~255) | (CT.ci[s] << 4) | CT.cj[s];
                else ck[s2] = (int)0x80000000;
            }
            sort16_desc(ck);
            if (gq == 0) {
#pragma unroll
                for (int i = 0; i < 16; ++i) top[i] = ck[i];
            } else merge16(top, ck);
        }
        float sc[16]; float ssum = 0.f;
        const float m0 = fromkey(top[0] & ~255);
#pragma unroll
        for (int i = 0; i < 16; ++i) { sc[i] = exp2f((fromkey(top[i] & ~255) - m0) * LOG2E); ssum += sc[i]; }
        const float rs = 1.f / ssum;
        const int head = 2 * hp + h;
        int* eo = eidx + ((size_t)(32 * tb + r) * 8 + head) * 16; float* go = gate + ((size_t)(32 * tb + r) * 8 + head) * 16;
#pragma unroll
        for (int q = 0; q < 4; ++q) {
            u32x4 ev; f32x4 gv;
#pragma unroll
            for (int e = 0; e < 4; ++e) {
                const int code = top[4 * q + e] & 255;
                const int i1 = scr[(code >> 4) * 64 + lane], i2 = scr[(16 + (code & 15)) * 64 + lane];
                ev[e] = (unsigned)(i1 * 128 + i2); gv[e] = sc[4 * q + e] * rs;
            }
            *(u32x4*)(eo + 4 * q) = ev; *(f32x4*)(go + 4 * q) = gv;
        }
    }
}

__device__ __forceinline__ float gelu_erf(float v) { return 0.5f * v * (1.f + erff(v * 0.70710678118654752f)); }
constexpr int EX_LIST = 0, EX_RING = 32768;
#define EX_CVT(w, hi) __builtin_amdgcn_cvt_pk_f32_fp8((int)(w), hi)
#define EX_DOT(uw, H, out) do { f32x2 s_ = EX_CVT((uw).x, false) * (H)[0]; s_ = __builtin_elementwise_fma(EX_CVT((uw).x, true), (H)[1], s_); \
    s_ = __builtin_elementwise_fma(EX_CVT((uw).y, false), (H)[2], s_); s_ = __builtin_elementwise_fma(EX_CVT((uw).y, true), (H)[3], s_); \
    s_ = __builtin_elementwise_fma(EX_CVT((uw).z, false), (H)[4], s_); s_ = __builtin_elementwise_fma(EX_CVT((uw).z, true), (H)[5], s_); \
    s_ = __builtin_elementwise_fma(EX_CVT((uw).w, false), (H)[6], s_); s_ = __builtin_elementwise_fma(EX_CVT((uw).w, true), (H)[7], s_); (out) = s_.x + s_.y; } while (0)
#define EX_ACC(vw, A, wv) do { const f32x2 w2_ = {(wv), (wv)}; \
    (A)[0] = __builtin_elementwise_fma(EX_CVT((vw).x, false), w2_, (A)[0]); (A)[1] = __builtin_elementwise_fma(EX_CVT((vw).x, true), w2_, (A)[1]); \
    (A)[2] = __builtin_elementwise_fma(EX_CVT((vw).y, false), w2_, (A)[2]); (A)[3] = __builtin_elementwise_fma(EX_CVT((vw).y, true), w2_, (A)[3]); \
    (A)[4] = __builtin_elementwise_fma(EX_CVT((vw).z, false), w2_, (A)[4]); (A)[5] = __builtin_elementwise_fma(EX_CVT((vw).z, true), w2_, (A)[5]); \
    (A)[6] = __builtin_elementwise_fma(EX_CVT((vw).w, false), w2_, (A)[6]); (A)[7] = __builtin_elementwise_fma(EX_CVT((vw).w, true), w2_, (A)[7]); } while (0)
#define EX_WAIT_V(n) asm volatile("s_waitcnt vmcnt(" #n ")" ::: "memory")
__device__ __forceinline__ void ex_glds16(const void* gsrc, unsigned lds_dst) { unsigned keep;
    asm volatile("s_mov_b32 %0, m0\n\ts_mov_b32 m0, %2\n\ts_nop 0\n\tglobal_load_lds_dwordx4 %1, off\n\ts_mov_b32 m0, %0" : "=&s"(keep) : "v"(gsrc), "s"(lds_dst) : "memory"); }
#define EX_ISSUE(gi, hb) do { const int g_ = (gi) < 128 ? (gi) : 127; unsigned e_[4]; \
    _Pragma("unroll") for (int j_ = 0; j_ < 4; ++j_) e_[j_] = (unsigned)__builtin_amdgcn_readfirstlane((int)plist[4 * g_ + j_].x) & 16383u; \
    asm volatile("s_waitcnt lgkmcnt(0)" ::: "memory"); \
    _Pragma("unroll") for (int j_ = 0; j_ < 4; ++j_) ex_glds16(ub8 + (size_t)e_[j_] * 1024 + 16 * lane, (unsigned)__builtin_amdgcn_readfirstlane((int)(ring_a + ((hb) * 8 + j_) * 1024))); \
    _Pragma("unroll") for (int j_ = 0; j_ < 4; ++j_) ex_glds16(vb8 + (size_t)e_[j_] * 1024 + 16 * lane, (unsigned)__builtin_amdgcn_readfirstlane((int)(ring_a + ((hb) * 8 + 4 + j_) * 1024))); } while (0)
#define EX_GROUP(gi, hb) do { unsigned E_[4]; float G_[4], S_[4]; float d_[4]; \
    _Pragma("unroll") for (int j_ = 0; j_ < 4; ++j_) { const u32x2 en_ = plist[4 * (gi) + j_]; E_[j_] = (unsigned)__builtin_amdgcn_readfirstlane((int)en_.x); \
        G_[j_] = __uint_as_float((unsigned)__builtin_amdgcn_readfirstlane((int)en_.y)); S_[j_] = __uint_as_float((E_[j_] >> 16) << 23); } \
    EX_WAIT_V(12); \
    _Pragma("unroll") for (int j_ = 0; j_ < 4; ++j_) { const u32x4 uw_ = *(const LAS u32x4*)(ring + ((hb) * 8 + j_) * 1024 + 16 * lane); const unsigned sl_ = (E_[j_] >> 14) & 3u; \
        if (sl_ == 0u) EX_DOT(uw_, hf[0], d_[j_]); else if (sl_ == 1u) EX_DOT(uw_, hf[1], d_[j_]); else if (sl_ == 2u) EX_DOT(uw_, hf[2], d_[j_]); else EX_DOT(uw_, hf[3], d_[j_]); } \
      \
    { const bool b0_ = lane & 1, b1_ = lane & 2; \
      float ka_ = b0_ ? d_[2] : d_[0], sa_ = b0_ ? d_[0] : d_[2], kb_ = b0_ ? d_[3] : d_[1], sb_ = b0_ ? d_[1] : d_[3]; \
      ka_ += __shfl_xor(sa_, 1); kb_ += __shfl_xor(sb_, 1); \
      float kc_ = b1_ ? kb_ : ka_, sc_ = b1_ ? ka_ : kb_; kc_ += __shfl_xor(sc_, 2); \
      kc_ += __shfl_xor(kc_, 4); kc_ += __shfl_xor(kc_, 8); kc_ += __shfl_xor(kc_, 16); kc_ += __shfl_xor(kc_, 32); \
      const float gs_ = b0_ ? (b1_ ? G_[3] : G_[2]) : (b1_ ? G_[1] : G_[0]); const float us_ = b0_ ? (b1_ ? S_[3] : S_[2]) : (b1_ ? S_[1] : S_[0]); \
      const float wl_ = gs_ * gelu_erf(kc_ * us_); \
      const int wi_ = (int)__float_as_uint(wl_); d_[0] = __uint_as_float((unsigned)__builtin_amdgcn_readlane(wi_, 0)); d_[1] = __uint_as_float((unsigned)__builtin_amdgcn_readlane(wi_, 2)); d_[2] = __uint_as_float((unsigned)__builtin_amdgcn_readlane(wi_, 1)); d_[3] = __uint_as_float((unsigned)__builtin_amdgcn_readlane(wi_, 3)); } \
    EX_WAIT_V(8); \
    _Pragma("unroll") for (int j_ = 0; j_ < 4; ++j_) { const u32x4 vw_ = *(const LAS u32x4*)(ring + ((hb) * 8 + 4 + j_) * 1024 + 16 * lane); const unsigned sl_ = (E_[j_] >> 14) & 3u; \
        if (sl_ == 0u) EX_ACC(vw_, acc[0], d_[j_]); else if (sl_ == 1u) EX_ACC(vw_, acc[1], d_[j_]); else if (sl_ == 2u) EX_ACC(vw_, acc[2], d_[j_]); else EX_ACC(vw_, acc[3], d_[j_]); } \
    EX_ISSUE((gi) + 2, hb); } while (0)

__device__ __forceinline__ void phase_expert(const Params& P, LAS unsigned char* lds) {
    const int tid = threadIdx.x, lane = tid & 63, wave = __builtin_amdgcn_readfirstlane(tid >> 6);
    const unsigned char* ub8 = P.ws + WS_UB8; const unsigned char* vb8 = P.ws + WS_VB8;
    const float* isu = (const float*)(P.ws + WS_ISU); const float* isv = (const float*)(P.ws + WS_ISV);
    const float* h1f = (const float*)(P.ws + WS_H1F);
    const int* eidx = (const int*)(P.ws + WS_EIDX); const float* gate = (const float*)(P.ws + WS_GATE);
    LAS u32x2* plist = (LAS u32x2*)(lds + EX_LIST + wave * 4096);
    LAS unsigned char* ring = lds + EX_RING + wave * 16384;
    volatile LAS unsigned* hist = (volatile LAS unsigned*)ring;
    const unsigned ring_a = (unsigned)(uintptr_t)ring;
    __syncthreads();
#pragma unroll 1
    for (int sweep = 0; sweep < 2; ++sweep) {
        const int t0 = 64 * (int)blockIdx.x + 8 * wave + 4 * sweep;
        hist[lane] = 0u;
        unsigned ev[8], rk[8]; float gs[8];
#pragma unroll
        for (int q = 0; q < 8; ++q) {
            const int j = q >> 1, k = lane + 64 * (q & 1);
            const unsigned e = (unsigned)eidx[(size_t)(t0 + j) * 128 + k];
            ev[q] = e | ((unsigned)j << 14) | ((__float_as_uint(isu[e]) >> 23) << 16); gs[q] = gate[(size_t)(t0 + j) * 128 + k] * isv[e];
        }
#pragma unroll
        for (int q = 0; q < 8; ++q) {
            const unsigned b = (ev[q] & 16383u) >> 8;
            unsigned long long m = ~0ull;
#pragma unroll
            for (int bit = 0; bit < 6; ++bit) { const bool on = (b >> bit) & 1u; const unsigned long long bal = __ballot(on); m &= on ? bal : ~bal; }
            const unsigned before = (unsigned)__popcll(m & ((1ull << lane) - 1ull)), cnt = (unsigned)__popcll(m);
            const unsigned old = hist[b];
            rk[q] = old + before;
            if (before == 0u) hist[b] = old + cnt;
        }
        { unsigned c = hist[lane], inc = c;
#pragma unroll
          for (int o = 1; o < 64; o <<= 1) { const unsigned n = __shfl_up(inc, o); if (lane >= o) inc += n; }
          hist[lane] = inc - c; }
#pragma unroll
        for (int q = 0; q < 8; ++q) {
            const unsigned b = (ev[q] & 16383u) >> 8;
            const unsigned pos = hist[b] + rk[q];
            u32x2 en; en.x = ev[q]; en.y = __float_as_uint(gs[q]);
            plist[pos] = en;
        }
        f32x2 hf[4][8], acc[4][8];
#pragma unroll
        for (int j = 0; j < 4; ++j) { const f32x4* hp = (const f32x4*)(h1f + (size_t)(t0 + j) * DM + 16 * lane);
#pragma unroll
            for (int q = 0; q < 4; ++q) { const f32x4 v = hp[q]; hf[j][2 * q] = (f32x2){v.x, v.y}; hf[j][2 * q + 1] = (f32x2){v.z, v.w}; acc[j][2 * q] = (f32x2){0.f, 0.f}; acc[j][2 * q + 1] = (f32x2){0.f, 0.f}; } }
        asm volatile("s_waitcnt vmcnt(0) lgkmcnt(0)" ::: "memory");
        EX_ISSUE(0, 0); EX_ISSUE(1, 1);
#pragma unroll 1
        for (int g = 0; g < 128; g += 2) { EX_GROUP(g, 0); EX_GROUP(g + 1, 1); }
        EX_WAIT_V(0);
#pragma unroll
        for (int j = 0; j < 4; ++j) {
            f32x2 v[8]; float s = 0.f;
#pragma unroll
            for (int q = 0; q < 8; ++q) { v[q] = hf[j][q] * DN_ALPHA + acc[j][q]; s += v[q].x + v[q].y; }
            const float mean = wave_sum(s) * (1.f / DM); float s2 = 0.f;
#pragma unroll
            for (int q = 0; q < 8; ++q) { v[q] = v[q] - mean; s2 += v[q].x * v[q].x + v[q].y * v[q].y; }
            const float rstd = 1.f / sqrtf(wave_sum(s2) * (1.f / DM) + LN_EPS);
            float* orow = P.out + (size_t)(t0 + j) * DM + 16 * lane;
#pragma unroll
            for (int q = 0; q < 4; ++q) {
                const f32x4 gg = *(const f32x4*)(P.ln2g + 16 * lane + 4 * q), bb = *(const f32x4*)(P.ln2b + 16 * lane + 4 * q);
                f32x4 o; o.x = v[2 * q].x * rstd * gg.x + bb.x; o.y = v[2 * q].y * rstd * gg.y + bb.y; o.z = v[2 * q + 1].x * rstd * gg.z + bb.z; o.w = v[2 * q + 1].y * rstd * gg.w + bb.w;
                *(f32x4*)(orow + 4 * q) = o;
            }
        }
        asm volatile("s_waitcnt vmcnt(0)" ::: "memory");
    }
}

#define XB_TMO      128
#define XB_XCNT(j)  (256  + 64 * (j))
#define XB_XSUB(j)  (1280 + 64 * (j))
#define XB_XGEN(j)  (2304 + 64 * (j))
#define XB_TOP      3328
#define XB_TOPGEN   3392
#define XCD_BAR_WORDS 3456
#define XB_SPIN_CAP (1u << 18)

__device__ __forceinline__ unsigned xb_ld(unsigned* p)              { return __hip_atomic_load(p, __ATOMIC_RELAXED, __HIP_MEMORY_SCOPE_AGENT); }
__device__ __forceinline__ unsigned xb_add(unsigned* p, unsigned v) { return __hip_atomic_fetch_add(p, v, __ATOMIC_RELAXED, __HIP_MEMORY_SCOPE_AGENT); }
__device__ __forceinline__ unsigned xb_xcc_id() { return (unsigned)__builtin_amdgcn_s_getreg((3 << 11) | 20) & 0xFu; }
#define XB_SPIN(cond, bar) do { unsigned _sp = 0; while (cond) { __builtin_amdgcn_s_sleep(1); \
    if ((++_sp & 255u) == 0u) { if (xb_ld(&(bar)[XB_TMO])) break; if (_sp > XB_SPIN_CAP) { atomicAdd(&(bar)[XB_TMO], 1u); break; } } } } while (0)

struct XcdBarrier {
    unsigned* bar; unsigned x;
    volatile LAS unsigned* st;
};

__device__ __forceinline__ XcdBarrier xcd_barrier_post(unsigned* bar, volatile LAS unsigned* st) {
    XcdBarrier b; b.bar = bar; b.x = xb_xcc_id(); b.st = st;
    if (threadIdx.x == 0) (void)xb_add(&bar[XB_XCNT(b.x)], 1u);
    return b;
}
__device__ __forceinline__ void xcd_barrier_complete(unsigned* bar, unsigned x, unsigned& nloc, unsigned& nx) {
    const unsigned G = gridDim.x * gridDim.y * gridDim.z;
    unsigned sum, cnt, mine, sp = 0u;
    for (;;) {
        sum = 0u; cnt = 0u; mine = 0u;
#pragma unroll
        for (unsigned j = 0; j < 16; ++j) { const unsigned c = xb_ld(&bar[XB_XCNT(j)]); sum += c; cnt += (c > 0u) ? 1u : 0u; mine = (j == x) ? c : mine; }
        if (sum == G) break;
        __builtin_amdgcn_s_sleep(1);
        if ((++sp & 255u) == 0u) { if (xb_ld(&bar[XB_TMO])) break; if (sp > XB_SPIN_CAP) { atomicAdd(&bar[XB_TMO], 1u); break; } }
    }
    nloc = mine > 0u ? mine : 1u; nx = cnt > 0u ? cnt : 1u;
}

__device__ __forceinline__ void xcd_barrier(const XcdBarrier& b) {
    asm volatile("s_waitcnt vmcnt(0)" ::: "memory");
    __syncthreads();
    if (threadIdx.x == 0) {
        unsigned* bar = b.bar;
        __builtin_amdgcn_s_waitcnt(0);
        unsigned nloc = b.st[0], nx = b.st[1];
        if (nloc == 0u) { xcd_barrier_complete(bar, b.x, nloc, nx); b.st[0] = nloc; b.st[1] = nx; }
        const unsigned old = xb_add(&bar[XB_XSUB(b.x)], 1u);
        const unsigned gen = old / nloc;
        if (old + 1u == (gen + 1u) * nloc) {
            __builtin_amdgcn_fence(__ATOMIC_RELEASE, "agent");
            asm volatile("s_waitcnt vmcnt(0)" ::: "memory");
            const unsigned og = xb_add(&bar[XB_TOP], 1u);
            const unsigned tg = og / nx;
            if (og + 1u == (tg + 1u) * nx) xb_add(&bar[XB_TOPGEN], 1u);
            else XB_SPIN(xb_ld(&bar[XB_TOPGEN]) == tg, bar);
            __builtin_amdgcn_fence(__ATOMIC_ACQUIRE, "agent");
            xb_add(&bar[XB_XGEN(b.x)], 1u);
            asm volatile("s_waitcnt vmcnt(0)" ::: "memory");
        } else {
            XB_SPIN(xb_ld(&bar[XB_XGEN(b.x)]) == gen, bar);
            __builtin_amdgcn_fence(__ATOMIC_ACQUIRE, "agent");
            asm volatile("s_waitcnt vmcnt(0)" ::: "memory");
        }
    }
    __syncthreads();
}

constexpr int MISC_OFF = LDS_BYTES - 256;
constexpr int CW_BAR = 4096;
constexpr size_t CTL_ZERO_BYTES = 65536;

__global__ void __launch_bounds__(NTHREADS, 2) fwd_megakernel(Params P) {
    extern __shared__ __attribute__((aligned(16))) unsigned char lds_raw[];
    LAS unsigned char* lds = (LAS unsigned char*)lds_raw;
    const int tid = threadIdx.x;
    volatile LAS unsigned* MISC = (volatile LAS unsigned*)(lds + MISC_OFF);
    if (tid < 64) MISC[tid] = 0u;
    __syncthreads();
    XcdBarrier bar = xcd_barrier_post((unsigned*)(P.ws + WS_CTL) + CW_BAR, MISC + 8);

    phase_prologue(P, lds);
    xcd_barrier(bar);
    { pg8::Gemm g{(const bf16*)(P.ws + WS_XB), (const bf16*)(P.ws + WS_WIN), NTOK, NPROJ, DM}; pg8::StaticOrder S; S.init(NTOK, NPROJ, gridDim.x, (int)blockIdx.x);
      pg8::EpiProj E{(bf16*)(P.ws + WS_PROJ), P.b_in, (const float*)(P.ws + WS_CS)};
      pg8::gemm_phase<pg8::EpiProj, pg8::StaticOrder, true, true>(lds, g, S, E); }
    xcd_barrier(bar);
    phase_attn(P, lds);
    xcd_barrier(bar);
    { pg8::Gemm g{(const bf16*)(P.ws + WS_Y), (const bf16*)(P.ws + WS_WOUT), NTOK, DM, DM}; pg8::StaticOrder S; S.init(NTOK, DM, gridDim.x, (int)blockIdx.x);
      pg8::EpiF32 E{P.out, DM, P.b_out};
      pg8::gemm_phase<pg8::EpiF32, pg8::StaticOrder, true, true>(lds, g, S, E); }
    xcd_barrier(bar);
    phase_ln1(P, P.out);
    xcd_barrier(bar);
    { pg8::Gemm g{(const bf16*)(P.ws + WS_H1B), (const bf16*)(P.ws + WS_WPQ), NTOK, NPQ, DM}; pg8::StaticOrder S; S.init(NTOK, NPQ, gridDim.x, (int)blockIdx.x);
      pg8::EpiBf16<0> E{(bf16*)P.out, NPQ, nullptr, 0, 0, 1.f};
      pg8::gemm_phase<pg8::EpiBf16<0>, pg8::StaticOrder, true, true>(lds, g, S, E); }
    xcd_barrier(bar);
    phase_topk(P, lds, (const bf16*)P.out);
    xcd_barrier(bar);
    phase_expert(P, lds);
}

extern "C" void kernel_launch(void* const* d_in, const int* in_sizes, int n_in, void* d_out, int out_size, void* d_ws, size_t ws_size, hipStream_t stream) {
    static int grid = 0;
    if (grid == 0) {
        if (n_in != 17 || out_size != NTOK * DM || ws_size < WS_END) { fprintf(stderr, "kernel_launch: unexpected shapes (n_in %d out %d ws %zu)\n", n_in, out_size, ws_size); grid = -1; return; }
        int dev = 0, cus = 0, per_cu = 0;
        if (hipGetDevice(&dev) != hipSuccess || hipDeviceGetAttribute(&cus, hipDeviceAttributeMultiprocessorCount, dev) != hipSuccess) { grid = -1; return; }
        if (hipFuncSetAttribute((const void*)fwd_megakernel, hipFuncAttributeMaxDynamicSharedMemorySize, LDS_BYTES) != hipSuccess) { fprintf(stderr, "kernel_launch: hipFuncSetAttribute failed\n"); grid = -1; return; }
        if (hipOccupancyMaxActiveBlocksPerMultiprocessor(&per_cu, (const void*)fwd_megakernel, NTHREADS, LDS_BYTES) != hipSuccess || per_cu < 1) { fprintf(stderr, "kernel_launch: occupancy query says %d blocks per CU\n", per_cu); (void)hipGetLastError(); grid = -1; return; }
        grid = cus;
        if (grid != 256) { fprintf(stderr, "kernel_launch: this kernel is built for a 256-CU device (got %d)\n", cus); grid = -1; return; }
    }
    if (grid < 0) return;
    if (hipMemsetAsync((char*)d_ws + WS_CTL, 0, CTL_ZERO_BYTES, stream) != hipSuccess) return;
    Params P{};
    P.x = (const float*)d_in[0]; P.pos = (const int*)d_in[1]; P.w_in = (const float*)d_in[2]; P.b_in = (const float*)d_in[3]; P.sinks = (const float*)d_in[4];
    P.conv_w = (const float*)d_in[5]; P.w_out = (const float*)d_in[6]; P.b_out = (const float*)d_in[7]; P.ln1g = (const float*)d_in[8]; P.ln1b = (const float*)d_in[9];
    P.w_pq = (const float*)d_in[10]; P.sk1 = (const float*)d_in[11]; P.sk2 = (const float*)d_in[12]; P.ue = (const float*)d_in[13]; P.ve = (const float*)d_in[14];
    P.ln2g = (const float*)d_in[15]; P.ln2b = (const float*)d_in[16]; P.out = (float*)d_out; P.ws = (unsigned char*)d_ws;
    hipLaunchKernelGGL(fwd_megakernel, dim3(grid), dim3(NTHREADS), LDS_BYTES, stream, P);
}
```

```cpp
#include <hip/hip_runtime.h>
#include <cstdio>
#include <cstdint>
namespace pg8 {
#define PG8_LAS __attribute__((address_space(3)))
typedef unsigned short bf16_t;
typedef short bf16x8 __attribute__((ext_vector_type(8)));
typedef float f32x4 __attribute__((ext_vector_type(4)));
typedef unsigned u32x4 __attribute__((ext_vector_type(4)));
constexpr int BM = 256, BK = 64, HALF = 128, HTB = HALF * BK * 2  , STAGE_BYTES = 8 * HTB, NXCD = 8, WGM = 8;

__host__ __device__ __forceinline__ int lds_byte(int r, int c) { const int st = (r >> 4) * 2 + (c >> 5), rr = r & 15, cc = c & 31, ob = rr * 64 + cc * 2; return st * 1024 + (ob ^ (((ob >> 9) & 1) << 5)); }
__host__ __device__ __forceinline__ void stage_rc(int b, int& R, int& C) { const int st = b / 1024, sb = b % 1024, swz = sb ^ (((sb >> 9) & 1) << 5); R = (st >> 1) * 16 + swz / 64; C = (st & 1) * 32 + (swz % 64) / 2; }
__host__ __device__ __forceinline__ int perm32(int rho) { const int n = rho >> 4, i = rho & 15; return 8 * (i >> 2) + 4 * n + (i & 3); }

struct Unit { int pm, pn; };
struct Gemm { const bf16_t* A; const bf16_t* Bt; int M, N, K; };

struct StaticOrder {
    int nM, nN, nwg, G, c;
    __host__ __device__ void init(int M, int N, int G_, int c_) { nM = M / BM; nN = N / BM; nwg = nM * nN; G = G_; c = c_; }
    __host__ __device__ bool next(int i, Unit& u) const {
        const long L = (long)i * G + c; if (L >= nwg) return false;
        int wgid = (int)L; { const int q = nwg / NXCD, r = nwg % NXCD, xcd = wgid % NXCD, off = wgid / NXCD; wgid = (xcd < r ? xcd * (q + 1) : r * (q + 1) + (xcd - r) * q) + off; }
        const int nig = WGM * nN, gid = wgid / nig, fm = gid * WGM, gsz = (nM - fm) < WGM ? (nM - fm) : WGM;
        u.pm = fm + ((wgid % nig) % gsz); u.pn = (wgid % nig) / gsz; return true;
    }
    __device__ __forceinline__ void a_ready(const Unit&) const {}
    __device__ __forceinline__ void done(const Unit&) const {}
};

__device__ __forceinline__ unsigned cvt_pk_bf16(float lo, float hi) { unsigned r; asm volatile("v_cvt_pk_bf16_f32 %0, %1, %2" : "=v"(r) : "v"(lo), "v"(hi)); return r; }
typedef float f32x2 __attribute__((ext_vector_type(2)));
__device__ __forceinline__ f32x2 gelu_pk(f32x2 v) {
    const f32x2 av = __builtin_elementwise_abs(v), d = av * 0.2316418882f + 1.0f;
    f32x2 t; t.x = __builtin_amdgcn_rcpf(d.x); t.y = __builtin_amdgcn_rcpf(d.y);
    f32x2 q = t * 0.5307027145f + (-0.7265760135f); q = q * t + 0.7107068705f; q = q * t + (-0.142248368f); q = q * t + 0.127414796f; q = q * t;
    const f32x2 s = (v * v) * (-0.72134752044f);
    f32x2 e; e.x = __builtin_amdgcn_exp2f(s.x); e.y = __builtin_amdgcn_exp2f(s.y);
    const f32x2 m = v * (q * e), r = v - m;
    f32x2 o; o.x = v.x < 0.f ? m.x : r.x; o.y = v.y < 0.f ? m.y : r.y; return o;
}

template <int ACT  > struct EpiBf16 {
    static constexpr bool PERM = true, AFTER_DRAIN = false; static_assert(ACT == 0 || ACT == 1, "EpiBf16: ACT is 0 (none) or 1 (gelu_pk)");
    bf16_t* O; int ldc; const float* bias; int split_cols; size_t split_stride; float scale0;
    __device__ __forceinline__ void operator()(const f32x4 (&acc)[2][2][4][2], const Unit& u, int wr, int wc, int fr, int fq) const {
        const int row0 = u.pm * BM + wr * 64 + fr; int colt = u.pn * BM; bf16_t* base = O;
        float sc = 1.f; if (split_cols) { const int t = colt / split_cols; base += (size_t)t * split_stride; colt -= t * split_cols; if (t == 0) sc = scale0; }
        const int col0 = colt + wc * 32 + 8 * fq, bcol0 = u.pn * BM + wc * 32 + 8 * fq;
        f32x4 bv[2][2];
#pragma unroll
        for (int bj = 0; bj < 2; ++bj)
#pragma unroll
            for (int n = 0; n < 2; ++n) bv[bj][n] = bias ? *(const f32x4*)(bias + bcol0 + bj * HALF + 4 * n) : (f32x4){0.f, 0.f, 0.f, 0.f};
#pragma unroll
        for (int ai = 0; ai < 2; ++ai)
#pragma unroll
            for (int m = 0; m < 4; ++m) { bf16_t* rowp = base + (size_t)(row0 + ai * HALF + m * 16) * ldc + col0;
#pragma unroll
                for (int bj = 0; bj < 2; ++bj) { f32x4 v0 = acc[ai][bj][m][0] + bv[bj][0], v1 = acc[ai][bj][m][1] + bv[bj][1];
                    if (ACT == 1) { f32x2 a = gelu_pk((f32x2){v0[0], v0[1]}), b = gelu_pk((f32x2){v0[2], v0[3]}), c = gelu_pk((f32x2){v1[0], v1[1]}), d = gelu_pk((f32x2){v1[2], v1[3]});
                        v0 = (f32x4){a.x, a.y, b.x, b.y}; v1 = (f32x4){c.x, c.y, d.x, d.y}; }
                    v0 = v0 * sc; v1 = v1 * sc; u32x4 w; w.x = cvt_pk_bf16(v0[0], v0[1]); w.y = cvt_pk_bf16(v0[2], v0[3]); w.z = cvt_pk_bf16(v1[0], v1[1]); w.w = cvt_pk_bf16(v1[2], v1[3]);
                    *(u32x4*)(rowp + bj * HALF) = w; } }
    }
};

struct PanelStats {
    unsigned* xbuf;
    unsigned* cnt;
    unsigned* tmo;
    int ntn; float eps;
    unsigned code;
    __device__ __forceinline__ bool run(const f32x4 (&v)[2][2][4][2], const Unit& u, int wr, int wc, int fr, int fq, PG8_LAS unsigned char* lds, int wid, int lane) const {
        typedef float f32x2v __attribute__((ext_vector_type(2)));
        PG8_LAS f32x2v* P = (PG8_LAS f32x2v*)lds;
        PG8_LAS f32x2v* S = (PG8_LAS f32x2v*)(lds + 8192);
        PG8_LAS unsigned* flag = (PG8_LAS unsigned*)(lds + 8192 + 2048);
#pragma unroll
        for (int ai = 0; ai < 2; ++ai)
#pragma unroll
            for (int m = 0; m < 4; ++m) {
                float s = 0.f;
#pragma unroll
                for (int bj = 0; bj < 2; ++bj)
#pragma unroll
                    for (int n = 0; n < 2; ++n) { const f32x4 x = v[ai][bj][m][n]; s += (x[0] + x[1]) + (x[2] + x[3]); }
                s += __shfl_xor(s, 16); s += __shfl_xor(s, 32);
                const float mw = s * (1.0f / 64.0f); float q = 0.f;
#pragma unroll
                for (int bj = 0; bj < 2; ++bj)
#pragma unroll
                    for (int n = 0; n < 2; ++n) { const f32x4 d = v[ai][bj][m][n] - mw; q += (d[0] * d[0] + d[1] * d[1]) + (d[2] * d[2] + d[3] * d[3]); }
                q += __shfl_xor(q, 16); q += __shfl_xor(q, 32);
                if (fq == 0) P[(ai * HALF + wr * 64 + m * 16 + fr) * 4 + wc] = (f32x2v){mw, q};
            }
        asm volatile("s_waitcnt lgkmcnt(0)" ::: "memory"); __builtin_amdgcn_s_barrier(); asm volatile("" ::: "memory");
#if defined(BROKEN_EXCHANGE_NO_WAIT)
#warning BROKEN CONTROL BUILD: the row-statistics exchange does not wait; results are wrong by design
        if (blockIdx.x >= 64) { const long long t0_ = clock64(); while (clock64() - t0_ < 60000) __builtin_amdgcn_s_sleep(8); }
#endif
        const int row = wid * 32 + (lane & 31);
        if (lane < 32) {
            const f32x2v a = P[row * 4 + 0], b = P[row * 4 + 1], c = P[row * 4 + 2], d = P[row * 4 + 3];
            const float mt = (a.x + b.x + c.x + d.x) * 0.25f;
            const float da = a.x - mt, db = b.x - mt, dc = c.x - mt, dd = d.x - mt;
            const float m2 = (a.y + b.y) + (c.y + d.y) + 64.0f * ((da * da + db * db) + (dc * dc + dd * dd));
            unsigned long long* slot = (unsigned long long*)xbuf + ((size_t)(u.pm * BM + row) * 4 + u.pn);
            __hip_atomic_store(slot, ((unsigned long long)__float_as_uint(m2) << 32) | __float_as_uint(mt), __ATOMIC_RELAXED, __HIP_MEMORY_SCOPE_AGENT);
        }
        asm volatile("s_waitcnt vmcnt(0)" ::: "memory");
        if (lane == 0) __hip_atomic_fetch_add(cnt + 64 * u.pm, 1u, __ATOMIC_RELAXED, __HIP_MEMORY_SCOPE_AGENT);
        if (wid == 0) {
            bool dead = false; const unsigned long long t0 = __builtin_amdgcn_s_memrealtime(); const unsigned want = 8u * (unsigned)ntn;
            for (;;) {
#if defined(BROKEN_EXCHANGE_NO_WAIT)
                break;
#endif
                if ((unsigned)__builtin_amdgcn_readfirstlane(__hip_atomic_load(cnt + 64 * u.pm, __ATOMIC_RELAXED, __HIP_MEMORY_SCOPE_AGENT)) >= want) break;
                if (__builtin_amdgcn_s_memrealtime() - t0 > 2000000ull) {
                    if (lane == 0) { unsigned expect = 0u; __hip_atomic_compare_exchange_strong(tmo + 1, &expect, code | (unsigned)(u.pm & 0xff), __ATOMIC_RELAXED, __ATOMIC_RELAXED, __HIP_MEMORY_SCOPE_AGENT);
                                     __hip_atomic_store(tmo, 1u, __ATOMIC_RELAXED, __HIP_MEMORY_SCOPE_AGENT); }
                    dead = true; break; }
                __builtin_amdgcn_s_sleep(2);
            }
            __builtin_amdgcn_fence(__ATOMIC_ACQUIRE, "agent");
            if (lane == 0) flag[0] = dead ? 1u : 0u;
        }
        asm volatile("s_waitcnt vmcnt(0) lgkmcnt(0)" ::: "memory"); __builtin_amdgcn_s_barrier(); asm volatile("" ::: "memory");
        const bool bad = flag[0] != 0u;
        if (lane < 32) {
            const unsigned long long* slot = (const unsigned long long*)xbuf + (size_t)(u.pm * BM + row) * 4; float mt[4], m2[4]; float ms = 0.f;
#pragma unroll
            for (int t = 0; t < 4; ++t) { if (t < ntn) { const unsigned long long w = __hip_atomic_load(slot + t, __ATOMIC_RELAXED, __HIP_MEMORY_SCOPE_AGENT); mt[t] = __uint_as_float((unsigned)w); m2[t] = __uint_as_float((unsigned)(w >> 32)); } else { mt[t] = 0.f; m2[t] = 0.f; } ms += mt[t]; }
            const float mean = ms / (float)ntn; float q = 0.f;
#pragma unroll
            for (int t = 0; t < 4; ++t) if (t < ntn) { const float dm = mt[t] - mean; q += m2[t] + 256.0f * dm * dm; }
            S[row] = (f32x2v){mean, 1.0f / sqrtf(q / (256.0f * (float)ntn) + eps)};
        }
        asm volatile("s_waitcnt lgkmcnt(0)" ::: "memory"); __builtin_amdgcn_s_barrier(); asm volatile("" ::: "memory");
        return bad;
    }
};
struct EpiLnRes {
    static constexpr bool PERM = false, AFTER_DRAIN = true;
    const float* base; float* out; int ldc; const float* bias; PanelStats st; unsigned poison;
    __device__ __forceinline__ void fused(f32x4 (&acc)[2][2][4][2], const Unit& u, int wr, int wc, int fr, int fq, PG8_LAS unsigned char* lds, int wid, int lane) const {
        typedef float f32x2v __attribute__((ext_vector_type(2)));
        const PG8_LAS f32x2v* S = (const PG8_LAS f32x2v*)(lds + 8192);
        const int col0 = u.pn * BM + wc * 32 + 4 * fq;
#pragma unroll
        for (int bj = 0; bj < 2; ++bj)
#pragma unroll
            for (int n = 0; n < 2; ++n) { const f32x4 bv = bias ? *(const f32x4*)(bias + col0 + bj * HALF + n * 16) : (f32x4){0.f, 0.f, 0.f, 0.f};
#pragma unroll
                for (int ai = 0; ai < 2; ++ai)
#pragma unroll
                    for (int m = 0; m < 4; ++m) acc[ai][bj][m][n] += bv; }
        f32x4 pre[4][2][2];
#pragma unroll
        for (int m = 0; m < 4; ++m) { const size_t off = (size_t)(u.pm * BM + wr * 64 + m * 16 + fr) * ldc + col0;
#pragma unroll
            for (int bj = 0; bj < 2; ++bj)
#pragma unroll
                for (int n = 0; n < 2; ++n) pre[m][bj][n] = *(const f32x4*)(base + off + bj * HALF + n * 16); }
        const bool bad = st.run(acc, u, wr, wc, fr, fq, lds, wid, lane) || poison != 0u;
        const float qnan = __builtin_nanf("");
#pragma unroll
        for (int ai = 0; ai < 2; ++ai)
#pragma unroll
            for (int m = 0; m < 4; ++m) { const int r = ai * HALF + wr * 64 + m * 16 + fr; const f32x2v sr = S[r]; const size_t off = (size_t)(u.pm * BM + r) * ldc + col0;
#pragma unroll
                for (int bj = 0; bj < 2; ++bj)
#pragma unroll
                    for (int n = 0; n < 2; ++n) { const f32x4 bs = ai == 0 ? pre[m][bj][n] : *(const f32x4*)(base + off + bj * HALF + n * 16); f32x4 o = bs + (acc[ai][bj][m][n] - sr.x) * sr.y;
                        if (bad) o = (f32x4){qnan, qnan, qnan, qnan}; *(f32x4*)(out + off + bj * HALF + n * 16) = o; }
                if (m & 1) asm volatile("" ::: "memory"); }
    }
};
struct EpiLnResLn {
    static constexpr bool PERM = false, AFTER_DRAIN = true;
    const float* base; float* out; bf16_t* xn; int ldc; const float* bias; PanelStats st1, st2; unsigned poison;
    __device__ __forceinline__ void fused(f32x4 (&acc)[2][2][4][2], const Unit& u, int wr, int wc, int fr, int fq, PG8_LAS unsigned char* lds, int wid, int lane) const {
        typedef float f32x2v __attribute__((ext_vector_type(2))); typedef unsigned u32x2v __attribute__((ext_vector_type(2)));
        const PG8_LAS f32x2v* S = (const PG8_LAS f32x2v*)(lds + 8192);
        const int col0 = u.pn * BM + wc * 32 + 4 * fq;
#pragma unroll
        for (int bj = 0; bj < 2; ++bj)
#pragma unroll
            for (int n = 0; n < 2; ++n) { const f32x4 bv = bias ? *(const f32x4*)(bias + col0 + bj * HALF + n * 16) : (f32x4){0.f, 0.f, 0.f, 0.f};
#pragma unroll
                for (int ai = 0; ai < 2; ++ai)
#pragma unroll
                    for (int m = 0; m < 4; ++m) acc[ai][bj][m][n] += bv; }
        bool bad = st1.run(acc, u, wr, wc, fr, fq, lds, wid, lane) || poison != 0u;
        const float qnan = __builtin_nanf("");
#pragma unroll
        for (int ai = 0; ai < 2; ++ai)
#pragma unroll
            for (int m = 0; m < 4; ++m) { const int r = ai * HALF + wr * 64 + m * 16 + fr; const f32x2v sr = S[r]; const size_t off = (size_t)(u.pm * BM + r) * ldc + col0;
#pragma unroll
                for (int bj = 0; bj < 2; ++bj)
#pragma unroll
                    for (int n = 0; n < 2; ++n) { const f32x4 bs = *(const f32x4*)(base + off + bj * HALF + n * 16); acc[ai][bj][m][n] = bs + (acc[ai][bj][m][n] - sr.x) * sr.y; }
                asm volatile("" : "+v"(acc[ai][0][m][0]), "+v"(acc[ai][0][m][1]), "+v"(acc[ai][1][m][0]), "+v"(acc[ai][1][m][1]));
                if (m & 1) asm volatile("" ::: "memory"); }
        const bool bad1 = bad;
        bad = st2.run(acc, u, wr, wc, fr, fq, lds, wid, lane) || bad;
#pragma unroll
        for (int ai = 0; ai < 2; ++ai)
#pragma unroll
            for (int m = 0; m < 4; ++m) { const int r = ai * HALF + wr * 64 + m * 16 + fr; const f32x2v sr = S[r]; const size_t off = (size_t)(u.pm * BM + r) * ldc + col0;
#pragma unroll
                for (int bj = 0; bj < 2; ++bj)
#pragma unroll
                    for (int n = 0; n < 2; ++n) { const f32x4 x1 = acc[ai][bj][m][n]; *(f32x4*)(out + off + bj * HALF + n * 16) = bad1 ? (f32x4){qnan, qnan, qnan, qnan} : x1;
                        const f32x4 o = (x1 - sr.x) * sr.y; u32x2v w; w.x = cvt_pk_bf16(o[0], o[1]); w.y = cvt_pk_bf16(o[2], o[3]);
                        if (bad) { w.x = 0x7fc07fc0u; w.y = 0x7fc07fc0u; } *(u32x2v*)(xn + off + bj * HALF + n * 16) = w; }
                asm volatile("" ::: "memory"); }
    }
};

template <class Epi, class Sched, bool ALIGN_EPI = false, bool SP2 = false>
__device__ __forceinline__ void gemm_phase(PG8_LAS unsigned char* lds, const Gemm g, const Sched& S, const Epi& E) {
    const int tid = threadIdx.x, wid = __builtin_amdgcn_readfirstlane(tid >> 6), lane = tid & 63, wr = wid >> 2, wc = wid & 3, fr = lane & 15, fq = lane >> 4;
    const int K = g.K, nt = K / BK;
    unsigned voffA[2], voffB[2];
#pragma unroll
    for (int i = 0; i < 2; ++i) { int R, C; stage_rc(tid * 16 + i * 8192, R, C); const int Rb = Epi::PERM ? ((R & ~31) + perm32(R & 31)) : R;
        voffA[i] = (unsigned)(R * K + C) * 2u; voffB[i] = (unsigned)(Rb * K + C) * 2u; }
    const size_t kstep = (size_t)(BK * 2);
    const size_t hstep = (size_t)HALF * K * 2;
    const size_t tstep = 2 * hstep;
    const unsigned ldsw = (unsigned)wid * 1024u;
    const int aoff = lds_byte(wr * 64 + fr, fq * 8), boff = lds_byte(wc * 32 + fr, fq * 8);
#define PG8_SA(b, h) (((b) * 2 + (h)) * HTB)
#define PG8_SB(b, h) ((4 + (b) * 2 + (h)) * HTB)
#define PG8_STAGE(bufoff, gbase, voff) do { _Pragma("unroll") for (int _i = 0; _i < 2; ++_i) \
        __builtin_amdgcn_global_load_lds((const unsigned*)((const char*)(gbase) + (voff)[_i]), (PG8_LAS unsigned*)(lds + (bufoff) + ldsw + _i * 8192), 16, 0, 0); } while (0)
#define PG8_LDA(dst, b, h) do { _Pragma("unroll") for (int m = 0; m < 4; ++m) _Pragma("unroll") for (int k = 0; k < 2; ++k) dst[m][k] = *(const PG8_LAS bf16x8*)(lds + PG8_SA(b, h) + aoff + m * 2048 + k * 1024); } while (0)
#define PG8_LDB(dst, b, h) do { _Pragma("unroll") for (int n = 0; n < 2; ++n) _Pragma("unroll") for (int k = 0; k < 2; ++k) dst[n][k] = *(const PG8_LAS bf16x8*)(lds + PG8_SB(b, h) + boff + n * 2048 + k * 1024); } while (0)
#define PG8_MMA(ai, bj, At, Bt) do { __builtin_amdgcn_s_setprio(1); _Pragma("unroll") for (int m = 0; m < 4; ++m) _Pragma("unroll") for (int n = 0; n < 2; ++n) _Pragma("unroll") for (int k = 0; k < 2; ++k) \
        acc[ai][bj][m][n] = __builtin_amdgcn_mfma_f32_16x16x32_bf16(Bt[n][k], At[m][k], acc[ai][bj][m][n], 0, 0, 0); __builtin_amdgcn_s_setprio(0); } while (0)
#define PG8_WAIT_V(n) asm volatile("s_waitcnt vmcnt(" #n ")" ::: "memory")
#define PG8_WAIT_L(n) asm volatile("s_waitcnt lgkmcnt(" #n ")" ::: "memory")
#define PG8_BAR __builtin_amdgcn_s_barrier()
#define PG8_SCHED __builtin_amdgcn_sched_barrier(0)
    Unit cur, nxt; int ui = 0;
    if (!S.next(0, cur)) return;
    f32x4 acc[2][2][4][2];
#pragma unroll
    for (int a = 0; a < 2; ++a)
#pragma unroll
        for (int b = 0; b < 2; ++b)
#pragma unroll
            for (int m = 0; m < 4; ++m)
#pragma unroll
                for (int n = 0; n < 2; ++n) acc[a][b][m][n] = (f32x4){0.f, 0.f, 0.f, 0.f};
    bf16x8 At[4][2], B0[2][2], B1[2][2];
    const char* cA = (const char*)g.A + (size_t)cur.pm * tstep; const char* cB = (const char*)g.Bt + (size_t)cur.pn * tstep;
    S.a_ready(cur);
    if constexpr (SP2) {
        PG8_STAGE(PG8_SB(0, 0), cB, voffB); PG8_STAGE(PG8_SB(0, 1), cB + hstep, voffB); PG8_STAGE(PG8_SA(0, 0), cA, voffA); PG8_STAGE(PG8_SA(0, 1), cA + hstep, voffA);
        if (wr == 1) PG8_BAR;
        PG8_WAIT_V(2); PG8_BAR;
        PG8_STAGE(PG8_SB(1, 0), cB + kstep, voffB); PG8_STAGE(PG8_SA(1, 0), cA + kstep, voffA); PG8_STAGE(PG8_SB(1, 1), cB + hstep + kstep, voffB);
        PG8_WAIT_V(6); PG8_BAR;
    } else {
        PG8_STAGE(PG8_SB(0, 0), cB, voffB); PG8_STAGE(PG8_SA(0, 0), cA, voffA); PG8_STAGE(PG8_SB(0, 1), cB + hstep, voffB); PG8_STAGE(PG8_SA(0, 1), cA + hstep, voffA);
        if (wr == 1) PG8_BAR;
        PG8_WAIT_V(4); PG8_BAR;
        PG8_STAGE(PG8_SB(1, 0), cB + kstep, voffB); PG8_STAGE(PG8_SA(1, 0), cA + kstep, voffA); PG8_STAGE(PG8_SB(1, 1), cB + hstep + kstep, voffB);
        PG8_WAIT_V(6); PG8_BAR;
    }
    for (;;) {
        const bool has_next = S.next(ui + 1, nxt);
        const char* nA = has_next ? (const char*)g.A + (size_t)nxt.pm * tstep : cA; const char* nB = has_next ? (const char*)g.Bt + (size_t)nxt.pn * tstep : cB;
        for (int t = 0; t < nt; t += 2) {
            const bool last = (t == nt - 2);
            const char* a1 = cA + (size_t)(t + 1) * kstep;
            const char* a2 = last ? nA : cA + (size_t)(t + 2) * kstep; const char* b2 = last ? nB : cB + (size_t)(t + 2) * kstep;
            const char* a3 = a2 + kstep; const char* b3 = b2 + kstep;
            if (last && has_next) S.a_ready(nxt);
            if constexpr (SP2) {
            PG8_LDB(B0, 0, 0); PG8_LDB(B1, 0, 1); PG8_SCHED; PG8_LDA(At, 0, 0); PG8_STAGE(PG8_SA(1, 1), a1 + hstep, voffA);
            PG8_WAIT_V(8); PG8_WAIT_L(0); PG8_BAR; PG8_MMA(0, 0, At, B0); PG8_MMA(0, 1, At, B1); PG8_BAR; PG8_SCHED;
            PG8_LDA(At, 0, 1); PG8_STAGE(PG8_SB(0, 0), b2, voffB); PG8_STAGE(PG8_SB(0, 1), b2 + hstep, voffB); PG8_STAGE(PG8_SA(0, 0), a2, voffA);
            PG8_WAIT_V(8); PG8_WAIT_L(0); PG8_BAR; PG8_MMA(1, 0, At, B0); PG8_MMA(1, 1, At, B1); PG8_BAR; PG8_SCHED;
            PG8_LDB(B0, 1, 0); PG8_LDB(B1, 1, 1); PG8_SCHED; PG8_LDA(At, 1, 0); PG8_STAGE(PG8_SA(0, 1), a2 + hstep, voffA);
            PG8_WAIT_V(8); PG8_WAIT_L(0); PG8_BAR; PG8_MMA(0, 0, At, B0); PG8_MMA(0, 1, At, B1); PG8_BAR; PG8_SCHED;
            PG8_LDA(At, 1, 1); PG8_STAGE(PG8_SB(1, 0), b3, voffB); PG8_STAGE(PG8_SB(1, 1), b3 + hstep, voffB); PG8_STAGE(PG8_SA(1, 0), a3, voffA);
            PG8_WAIT_V(8); PG8_WAIT_L(0); PG8_BAR; PG8_MMA(1, 0, At, B0); PG8_MMA(1, 1, At, B1); PG8_BAR; PG8_SCHED;
            } else {
            PG8_LDB(B0, 0, 0); PG8_SCHED; PG8_LDA(At, 0, 0); PG8_STAGE(PG8_SA(1, 1), a1 + hstep, voffA);
            PG8_WAIT_L(8); PG8_BAR; PG8_WAIT_L(0); PG8_MMA(0, 0, At, B0); PG8_BAR; PG8_SCHED;
            PG8_LDB(B1, 0, 1); PG8_STAGE(PG8_SB(0, 0), b2, voffB);
            PG8_BAR; PG8_WAIT_L(0); PG8_MMA(0, 1, At, B1); PG8_BAR;
            PG8_LDA(At, 0, 1); PG8_STAGE(PG8_SA(0, 0), a2, voffA);
            PG8_BAR; PG8_WAIT_L(0); PG8_MMA(1, 0, At, B0); PG8_BAR; PG8_SCHED;
            PG8_STAGE(PG8_SB(0, 1), b2 + hstep, voffB);
            PG8_WAIT_V(6); PG8_BAR; PG8_MMA(1, 1, At, B1); PG8_BAR;
            PG8_LDB(B0, 1, 0); PG8_SCHED; PG8_LDA(At, 1, 0); PG8_STAGE(PG8_SA(0, 1), a2 + hstep, voffA);
            PG8_WAIT_L(8); PG8_BAR; PG8_WAIT_L(0); PG8_MMA(0, 0, At, B0); PG8_BAR; PG8_SCHED;
            PG8_LDB(B1, 1, 1); PG8_STAGE(PG8_SB(1, 0), b3, voffB);
            PG8_BAR; PG8_WAIT_L(0); PG8_MMA(0, 1, At, B1); PG8_BAR;
            PG8_LDA(At, 1, 1); PG8_STAGE(PG8_SA(1, 0), a3, voffA);
            PG8_BAR; PG8_WAIT_L(0); PG8_MMA(1, 0, At, B0); PG8_BAR; PG8_SCHED;
            PG8_STAGE(PG8_SB(1, 1), b3 + hstep, voffB);
            PG8_WAIT_V(6); PG8_BAR; PG8_MMA(1, 1, At, B1); PG8_BAR;
            }
        }
        if constexpr (ALIGN_EPI) { if (wr == 0) PG8_BAR; }
        if constexpr (!Epi::AFTER_DRAIN) { E(acc, cur, wr, wc, fr, fq); S.done(cur); }
        if (!has_next) break;
#pragma unroll
        for (int a = 0; a < 2; ++a)
#pragma unroll
            for (int b = 0; b < 2; ++b)
#pragma unroll
                for (int m = 0; m < 4; ++m)
#pragma unroll
                    for (int n = 0; n < 2; ++n) acc[a][b][m][n] = (f32x4){0.f, 0.f, 0.f, 0.f};
        cur = nxt; cA = nA; cB = nB; ++ui;
        if constexpr (ALIGN_EPI) { if (wr == 1) PG8_BAR; }
    }
    PG8_WAIT_V(0);
    if constexpr (!ALIGN_EPI) { if (wr == 0) PG8_BAR; }
    PG8_BAR;
    if constexpr (Epi::AFTER_DRAIN) { E.fused(acc, cur, wr, wc, fr, fq, lds, wid, lane); S.done(cur); }
#undef PG8_SA
#undef PG8_SB
#undef PG8_STAGE
#undef PG8_LDA
#undef PG8_LDB
#undef PG8_MMA
#undef PG8_WAIT_V
#undef PG8_WAIT_L
#undef PG8_BAR
#undef PG8_SCHED
}
}

#define LAS __attribute__((address_space(3)))
typedef unsigned short bf16;
typedef float f32x4 __attribute__((ext_vector_type(4)));
typedef float f32x16 __attribute__((ext_vector_type(16)));
typedef unsigned u32x4 __attribute__((ext_vector_type(4)));
typedef unsigned u32x2 __attribute__((ext_vector_type(2)));
typedef short bf16x8 __attribute__((ext_vector_type(8)));
typedef float f32x2 __attribute__((ext_vector_type(2)));

constexpr int NTOK = 16384, DM = 1024, SEQ = 8192, NPROJ = 2304, NPQ = 2048, NEXP = 16384;
constexpr float DN_ALPHA = 1.189207115002721f;
constexpr float LN_EPS = 1e-5f;
constexpr float LOG2E = 1.4426950408889634f;
constexpr int NWAVES = 8, NTHREADS = 512;
constexpr int LDS_BYTES = 163840;

constexpr size_t MiB = 1u << 20;
constexpr size_t WS_CTL = 0, WS_WIN = 1 * MiB, WS_WOUT = 6 * MiB, WS_WPQ = 8 * MiB, WS_CS = 12 * MiB;
constexpr size_t WS_UB = 16 * MiB, WS_VB = 48 * MiB, WS_XB = 80 * MiB, WS_Y = 80 * MiB;
constexpr size_t WS_UB8 = 16 * MiB, WS_VB8 = 32 * MiB, WS_ISU = 14 * MiB, WS_ISV = 15 * MiB;
constexpr size_t WS_PROJ = 112 * MiB, WS_H1F = 112 * MiB, WS_H1B = 184 * MiB, WS_EIDX = 216 * MiB, WS_GATE = 224 * MiB, WS_END = 232 * MiB;

struct Params {
    const float* x; const int* pos; const float* w_in; const float* b_in; const float* sinks; const float* conv_w; const float* w_out; const float* b_out;
    const float* ln1g; const float* ln1b; const float* w_pq; const float* sk1; const float* sk2; const float* ue; const float* ve; const float* ln2g; const float* ln2b;
    float* out; unsigned char* ws;
};

__device__ __forceinline__ unsigned f2bf(float f) { unsigned u = __builtin_bit_cast(unsigned, f); return (u + 0x7fffu + ((u >> 16) & 1u)) >> 16; }
__device__ __forceinline__ unsigned pk2(float lo, float hi) { return f2bf(lo) | (f2bf(hi) << 16); }
__device__ __forceinline__ float bf_lo(unsigned w) { return __builtin_bit_cast(float, w << 16); }
__device__ __forceinline__ float bf_hi(unsigned w) { return __builtin_bit_cast(float, w & 0xffff0000u); }
__device__ __forceinline__ float wave_sum(float v) {
#pragma unroll
    for (int o = 1; o < 64; o <<= 1) v += __shfl_xor(v, o);
    return v;
}

__constant__ double ROPE_INVF[8] = {1.0, 0.19392274474868576, 0.03760603093086393, 0.007292664737217109, 0.001414213562373095, 0.0002742481756762073, 5.318295896944988e-05, 1.031338537721246e-05};

namespace pg8 {
struct EpiProj {
    static constexpr bool PERM = true, AFTER_DRAIN = false;
    bf16_t* O; const float* bias; const float* cs;
    __device__ __forceinline__ void operator()(const f32x4 (&acc)[2][2][4][2], const Unit& u, int wr, int wc, int fr, int fq) const {
        const int row0 = u.pm * BM + wr * 64 + fr;
        const int col0 = u.pn * BM + wc * 32 + 8 * fq;
        f32x4 bv[2][2];
#pragma unroll
        for (int bj = 0; bj < 2; ++bj)
#pragma unroll
            for (int n = 0; n < 2; ++n) bv[bj][n] = *(const f32x4*)(bias + col0 + bj * HALF + 4 * n);
        const bool rope_wave = (u.pn <= 2) && ((wc & 1) == 0);
#pragma unroll
        for (int ai = 0; ai < 2; ++ai)
#pragma unroll
            for (int m = 0; m < 4; ++m) {
                const int row = row0 + ai * HALF + m * 16;
                bf16_t* rowp = O + (size_t)row * 2304 + col0;
                f32x4 c0 = {1.f, 0.f, 1.f, 0.f}, c1 = c0, c2 = c0, c3 = c0;
                if (rope_wave && fq < 2) { const f32x4* cp = (const f32x4*)(cs + (size_t)row * 16); c0 = cp[0]; c1 = cp[1]; c2 = cp[2]; c3 = cp[3]; }
#pragma unroll
                for (int bj = 0; bj < 2; ++bj) {
                    f32x4 v0 = acc[ai][bj][m][0] + bv[bj][0], v1 = acc[ai][bj][m][1] + bv[bj][1];
                    if (rope_wave && (u.pn < 2 || bj == 0)) {
                        f32x4 p0, p1;
#pragma unroll
                        for (int e = 0; e < 4; ++e) { p0[e] = __shfl_xor(v0[e], 16); p1[e] = __shfl_xor(v1[e], 16); }
                        if (fq < 2) {
                            const float sg = (fq == 0) ? -1.f : 1.f;
                            v0[0] = v0[0] * c0[0] + sg * p0[0] * c0[1]; v0[1] = v0[1] * c0[2] + sg * p0[1] * c0[3];
                            v0[2] = v0[2] * c1[0] + sg * p0[2] * c1[1]; v0[3] = v0[3] * c1[2] + sg * p0[3] * c1[3];
                            v1[0] = v1[0] * c2[0] + sg * p1[0] * c2[1]; v1[1] = v1[1] * c2[2] + sg * p1[1] * c2[3];
                            v1[2] = v1[2] * c3[0] + sg * p1[2] * c3[1]; v1[3] = v1[3] * c3[2] + sg * p1[3] * c3[3];
                        }
                    }
                    u32x4 w; w.x = cvt_pk_bf16(v0[0], v0[1]); w.y = cvt_pk_bf16(v0[2], v0[3]); w.z = cvt_pk_bf16(v1[0], v1[1]); w.w = cvt_pk_bf16(v1[2], v1[3]);
                    *(u32x4*)(rowp + bj * HALF) = w;
                }
            }
    }
};
struct EpiF32 {
    static constexpr bool PERM = false, AFTER_DRAIN = false;
    float* O; int ldc; const float* bias;
    __device__ __forceinline__ void operator()(const f32x4 (&acc)[2][2][4][2], const Unit& u, int wr, int wc, int fr, int fq) const {
        const int row0 = u.pm * BM + wr * 64 + fr;
        const int col0 = u.pn * BM + wc * 32 + 4 * fq;
#pragma unroll
        for (int bj = 0; bj < 2; ++bj)
#pragma unroll
            for (int n = 0; n < 2; ++n) {
                const f32x4 bv = *(const f32x4*)(bias + col0 + bj * HALF + n * 16);
#pragma unroll
                for (int ai = 0; ai < 2; ++ai)
#pragma unroll
                    for (int m = 0; m < 4; ++m) *(f32x4*)(O + (size_t)(row0 + ai * HALF + m * 16) * ldc + col0 + bj * HALF + n * 16) = acc[ai][bj][m][n] + bv;
            }
    }
};
}

__device__ __forceinline__ void p0_transpose_item(const float* W, int K, int N, bf16* WT, LAS float* scr, int item, int lane) {
    const int nblk = N / 32, kb = item / nblk, nb = item % nblk, k0 = 64 * kb, n0 = 32 * nb;
#pragma unroll 8
    for (int i = 0; i < 32; ++i) { const int kk = 2 * i + (lane >> 5); scr[kk * 33 + (lane & 31)] = W[(size_t)(k0 + kk) * N + n0 + (lane & 31)]; }
    asm volatile("s_waitcnt lgkmcnt(0)" ::: "memory");
    const int c = lane & 7;
#pragma unroll
    for (int j = 0; j < 4; ++j) { const int n = (lane >> 3) + 8 * j; const LAS float* s = scr + (8 * c) * 33 + n;
        u32x4 o; o.x = pk2(s[0 * 33], s[1 * 33]); o.y = pk2(s[2 * 33], s[3 * 33]); o.z = pk2(s[4 * 33], s[5 * 33]); o.w = pk2(s[6 * 33], s[7 * 33]);
        *(u32x4*)(WT + (size_t)(n0 + n) * K + k0 + 8 * c) = o; }
    asm volatile("s_waitcnt lgkmcnt(0)" ::: "memory");
}
__device__ __forceinline__ void row_to_bf16(const float* src, bf16* dst, int lane) {
    const f32x4* s = (const f32x4*)src + lane; unsigned long long* o = (unsigned long long*)dst + lane;
#pragma unroll
    for (int j = 0; j < 4; ++j) { const f32x4 v = s[64 * j]; o[64 * j] = (unsigned long long)pk2(v.x, v.y) | ((unsigned long long)pk2(v.z, v.w) << 32); }
}
__device__ __forceinline__ void phase_prologue(const Params& P, LAS unsigned char* lds) {
    const int tid = threadIdx.x, lane = tid & 63, wave = __builtin_amdgcn_readfirstlane(tid >> 6);
    const int gw = blockIdx.x * NWAVES + wave, NGW = gridDim.x * NWAVES;
    LAS float* scr = (LAS float*)(lds + wave * 16384);
    constexpr int I_IN = 16 * (NPROJ / 32), I_OUT = 16 * (DM / 32), I_PQ = 16 * (NPQ / 32);
    for (int it = gw; it < I_IN + I_OUT + I_PQ; it += NGW) {
        int r = it;
        if (r < I_IN) { p0_transpose_item(P.w_in, DM, NPROJ, (bf16*)(P.ws + WS_WIN), scr, r, lane); continue; } r -= I_IN;
        if (r < I_OUT) { p0_transpose_item(P.w_out, DM, DM, (bf16*)(P.ws + WS_WOUT), scr, r, lane); continue; } r -= I_OUT;
        p0_transpose_item(P.w_pq, DM, NPQ, (bf16*)(P.ws + WS_WPQ), scr, r, lane);
    }
    for (int m = gw; m < NTOK; m += NGW) row_to_bf16(P.x + (size_t)m * DM, (bf16*)(P.ws + WS_XB) + (size_t)m * DM, lane);
    for (int m = gw; m < 2 * NEXP; m += NGW) {
        const int which = m >> 14, r = m & 16383;
        const f32x4* sp = (const f32x4*)((which ? P.ve : P.ue) + (size_t)r * DM + 16 * lane);
        f32x4 v[4]; float mx = 0.f;
#pragma unroll
        for (int q = 0; q < 4; ++q) { v[q] = sp[q]; mx = fmaxf(mx, fmaxf(fmaxf(fabsf(v[q].x), fabsf(v[q].y)), fmaxf(fabsf(v[q].z), fabsf(v[q].w)))); }
#pragma unroll
        for (int o = 1; o < 64; o <<= 1) mx = fmaxf(mx, __shfl_xor(mx, o));
        const float sc = mx > 0.f ? __uint_as_float(__float_as_uint(256.f / mx) & 0x7f800000u) : 1.f, inv = 1.f / sc;
        u32x4 w;
#pragma unroll
        for (int q = 0; q < 4; ++q) { int p = __builtin_amdgcn_cvt_pk_fp8_f32(v[q].x * sc, v[q].y * sc, 0, false); p = __builtin_amdgcn_cvt_pk_fp8_f32(v[q].z * sc, v[q].w * sc, p, true); w[q] = (unsigned)p; }
        *(u32x4*)(P.ws + (which ? WS_VB8 : WS_UB8) + (size_t)r * 1024 + 16 * lane) = w;
        if (lane == 0) ((float*)(P.ws + (which ? WS_ISV : WS_ISU)))[r] = inv;
    }
    float* cs = (float*)(P.ws + WS_CS);
    for (int e = blockIdx.x * NTHREADS + tid; e < NTOK * 8; e += gridDim.x * NTHREADS) {
        const int t = e >> 3, i = e & 7;
        const double ang = (double)P.pos[t] * ROPE_INVF[i];
        double sn, cn; sincos(ang, &sn, &cn);
        cs[2 * e] = (float)cn; cs[2 * e + 1] = (float)sn;
    }
}

__device__ __forceinline__ void phase_attn(const Params& P, LAS unsigned char* lds) {
    const int tid = threadIdx.x, lane = tid & 63, wave = __builtin_amdgcn_readfirstlane(tid >> 6), r = lane & 31, h = lane >> 5;
    const bf16* proj = (const bf16*)(P.ws + WS_PROJ); bf16* y = (bf16*)(P.ws + WS_Y);
    LAS unsigned char* Kl = lds;
    LAS unsigned char* Vt = lds + 36864;
    for (int unit = blockIdx.x; unit < 256; unit += gridDim.x) {
        const int b = unit >> 7, n = (unit >> 1) & 63, hk = unit & 1;
        const int tok0 = b * SEQ + n * 128;
        __syncthreads();
#pragma unroll
        for (int i = 0; i < 4; ++i) {
            const int row = (tid >> 3) + 64 * i, ch = tid & 7;
            const bool valid = (n > 0) || (row >= 128);
            u32x4 kv = {0u, 0u, 0u, 0u}, vv = {0u, 0u, 0u, 0u};
            if (valid) { const bf16* src = proj + (size_t)(tok0 - 128 + row) * NPROJ + 512 + hk * 64 + ch * 8; kv = *(const u32x4*)src; vv = *(const u32x4*)(src + 128); }
            *(LAS u32x4*)(Kl + row * 144 + ch * 16) = kv;
            LAS unsigned short* vt = (LAS unsigned short*)(Vt + (ch * 8) * 520 + row * 2);
            vt[0 * 260] = (unsigned short)(vv.x & 0xffffu); vt[1 * 260] = (unsigned short)(vv.x >> 16);
            vt[2 * 260] = (unsigned short)(vv.y & 0xffffu); vt[3 * 260] = (unsigned short)(vv.y >> 16);
            vt[4 * 260] = (unsigned short)(vv.z & 0xffffu); vt[5 * 260] = (unsigned short)(vv.z >> 16);
            vt[6 * 260] = (unsigned short)(vv.w & 0xffffu); vt[7 * 260] = (unsigned short)(vv.w >> 16);
        }
        __syncthreads();
        const int g = wave >> 1, qh = wave & 1, head = hk * 4 + g;
        const float sink = P.sinks[head];
#pragma unroll 1
        for (int blk = 0; blk < 2; ++blk) {
            const int qb = 2 * qh + blk, q0 = 32 * qb;
            const bf16* qp = proj + (size_t)(tok0 + q0 + r) * NPROJ + head * 64 + 8 * h;
            bf16x8 qf[4];
#pragma unroll
            for (int s = 0; s < 4; ++s) qf[s] = *(const bf16x8*)(qp + 16 * s);
            f32x16 st[5];
#pragma unroll
            for (int kt5 = 0; kt5 < 5; ++kt5) {
                f32x16 acc;
#pragma unroll
                for (int i = 0; i < 16; ++i) acc[i] = 0.f;
                const LAS unsigned char* kp = Kl + ((qb + kt5) * 32 + r) * 144 + 16 * h;
#pragma unroll
                for (int s = 0; s < 4; ++s) { const bf16x8 a = *(const LAS bf16x8*)(kp + 32 * s); acc = __builtin_amdgcn_mfma_f32_32x32x16_bf16(a, qf[s], acc, 0, 0, 0); }
                st[kt5] = acc;
            }
            float mx = -INFINITY;
#pragma unroll
            for (int kt5 = 0; kt5 < 5; ++kt5)
#pragma unroll
                for (int i = 0; i < 16; ++i) {
                    const int keyrow = (i & 3) + 8 * (i >> 2) + 4 * h;
                    const int kj = (qb + kt5) * 32 + keyrow, rel = 32 * kt5 + keyrow - r;
                    const bool valid = (rel >= 1) && (rel <= 128) && (n > 0 || kj >= 128);
                    const float v = valid ? st[kt5][i] * 0.125f : -INFINITY;
                    st[kt5][i] = v; mx = fmaxf(mx, v);
                }
            mx = fmaxf(mx, __shfl_xor(mx, 32)); mx = fmaxf(mx, sink);
            float l = 0.f;
#pragma unroll
            for (int kt5 = 0; kt5 < 5; ++kt5)
#pragma unroll
                for (int i = 0; i < 16; ++i) { const float p = exp2f((st[kt5][i] - mx) * LOG2E); st[kt5][i] = p; l += p; }
            l += __shfl_xor(l, 32); l += exp2f((sink - mx) * LOG2E);
            f32x16 ot[2];
#pragma unroll
            for (int i = 0; i < 16; ++i) { ot[0][i] = 0.f; ot[1][i] = 0.f; }
#pragma unroll
            for (int kt5 = 0; kt5 < 5; ++kt5)
#pragma unroll
                for (int s2 = 0; s2 < 2; ++s2) {
                    u32x4 w; w.x = pk2(st[kt5][8 * s2 + 0], st[kt5][8 * s2 + 1]); w.y = pk2(st[kt5][8 * s2 + 2], st[kt5][8 * s2 + 3]);
                    w.z = pk2(st[kt5][8 * s2 + 4], st[kt5][8 * s2 + 5]); w.w = pk2(st[kt5][8 * s2 + 6], st[kt5][8 * s2 + 7]);
                    const bf16x8 pb = __builtin_bit_cast(bf16x8, w);
                    const int base = (qb + kt5) * 32 + 16 * s2 + 4 * h;
#pragma unroll
                    for (int dblk = 0; dblk < 2; ++dblk) {
                        const LAS unsigned char* vp = Vt + (32 * dblk + r) * 520 + base * 2;
                        const u32x2 lo = *(const LAS u32x2*)vp, hi = *(const LAS u32x2*)(vp + 16);
                        u32x4 aw; aw.x = lo.x; aw.y = lo.y; aw.z = hi.x; aw.w = hi.y;
                        ot[dblk] = __builtin_amdgcn_mfma_f32_32x32x16_bf16(__builtin_bit_cast(bf16x8, aw), pb, ot[dblk], 0, 0, 0);
                    }
                }
            const float inv = 1.f / l;
            bf16* yp = y + (size_t)(tok0 + q0 + r) * DM + head * 64;
#pragma unroll
            for (int dblk = 0; dblk < 2; ++dblk)
#pragma unroll
                for (int g4 = 0; g4 < 4; ++g4) {
                    u32x2 o; o.x = pk2(ot[dblk][4 * g4] * inv, ot[dblk][4 * g4 + 1] * inv); o.y = pk2(ot[dblk][4 * g4 + 2] * inv, ot[dblk][4 * g4 + 3] * inv);
                    *(u32x2*)(yp + 32 * dblk + 8 * g4 + 4 * h) = o;
                }
        }
        {
            const int cc = tid & 31, tg = tid >> 5, c0 = 256 * hk + 8 * cc;
            float w0[8], w1[8], w2[8], p1[8], p2[8];
#pragma unroll
            for (int e = 0; e < 8; ++e) { w0[e] = P.conv_w[c0 + e]; w1[e] = P.conv_w[512 + c0 + e]; w2[e] = P.conv_w[1024 + c0 + e]; p1[e] = 0.f; p2[e] = 0.f; }
            const int tl0 = 128 * n + 8 * tg;
#pragma unroll
            for (int k = 2; k >= 1; --k) {
                const int tloc = tl0 - k;
                if (tloc >= 0) {
                    const bf16* src = proj + (size_t)(b * SEQ + tloc) * NPROJ + c0;
                    const u32x4 gc = *(const u32x4*)(src + 1280), xc = *(const u32x4*)(src + 1792);
                    float pv[8];
                    pv[0] = bf_lo(gc.x) * bf_lo(xc.x); pv[1] = bf_hi(gc.x) * bf_hi(xc.x); pv[2] = bf_lo(gc.y) * bf_lo(xc.y); pv[3] = bf_hi(gc.y) * bf_hi(xc.y);
                    pv[4] = bf_lo(gc.z) * bf_lo(xc.z); pv[5] = bf_hi(gc.z) * bf_hi(xc.z); pv[6] = bf_lo(gc.w) * bf_lo(xc.w); pv[7] = bf_hi(gc.w) * bf_hi(xc.w);
#pragma unroll
                    for (int e = 0; e < 8; ++e) { if (k == 2) p2[e] = pv[e]; else p1[e] = pv[e]; }
                }
            }
#pragma unroll 2
            for (int j = 0; j < 8; ++j) {
                const size_t row = (size_t)(b * SEQ + tl0 + j);
                const bf16* src = proj + row * NPROJ + c0;
                const u32x4 gb = *(const u32x4*)(src + 768), gc = *(const u32x4*)(src + 1280), xc = *(const u32x4*)(src + 1792);
                float p0[8], gbf[8], o[8];
                p0[0] = bf_lo(gc.x) * bf_lo(xc.x); p0[1] = bf_hi(gc.x) * bf_hi(xc.x); p0[2] = bf_lo(gc.y) * bf_lo(xc.y); p0[3] = bf_hi(gc.y) * bf_hi(xc.y);
                p0[4] = bf_lo(gc.z) * bf_lo(xc.z); p0[5] = bf_hi(gc.z) * bf_hi(xc.z); p0[6] = bf_lo(gc.w) * bf_lo(xc.w); p0[7] = bf_hi(gc.w) * bf_hi(xc.w);
                gbf[0] = bf_lo(gb.x); gbf[1] = bf_hi(gb.x); gbf[2] = bf_lo(gb.y); gbf[3] = bf_hi(gb.y); gbf[4] = bf_lo(gb.z); gbf[5] = bf_hi(gb.z); gbf[6] = bf_lo(gb.w); gbf[7] = bf_hi(gb.w);
#pragma unroll
                for (int e = 0; e < 8; ++e) { o[e] = gbf[e] * (w0[e] * p2[e] + w1[e] * p1[e] + w2[e] * p0[e]); p2[e] = p1[e]; p1[e] = p0[e]; }
                u32x4 ow; ow.x = pk2(o[0], o[1]); ow.y = pk2(o[2], o[3]); ow.z = pk2(o[4], o[5]); ow.w = pk2(o[6], o[7]);
                *(u32x4*)(y + row * DM + 512 + c0) = ow;
            }
        }
    }
}

__device__ __forceinline__ void phase_ln1(const Params& P, const float* mix) {
    const int tid = threadIdx.x, lane = tid & 63, wave = __builtin_amdgcn_readfirstlane(tid >> 6);
    const int gw = blockIdx.x * NWAVES + wave, NGW = gridDim.x * NWAVES;
    float* h1f = (float*)(P.ws + WS_H1F); bf16* h1b = (bf16*)(P.ws + WS_H1B);
    f32x4 gg[4], bb[4];
#pragma unroll
    for (int j = 0; j < 4; ++j) { gg[j] = ((const f32x4*)P.ln1g)[lane + 64 * j]; bb[j] = ((const f32x4*)P.ln1b)[lane + 64 * j]; }
    for (int m = gw; m < NTOK; m += NGW) {
        const f32x4* xr = (const f32x4*)(P.x + (size_t)m * DM) + lane; const f32x4* mr = (const f32x4*)(mix + (size_t)m * DM) + lane;
        f32x4 v[4]; float s = 0.f;
#pragma unroll
        for (int j = 0; j < 4; ++j) { v[j] = xr[64 * j] * DN_ALPHA + mr[64 * j]; s += (v[j].x + v[j].y) + (v[j].z + v[j].w); }
        const float mean = wave_sum(s) * (1.f / DM); float s2 = 0.f;
#pragma unroll
        for (int j = 0; j < 4; ++j) { v[j] = v[j] - mean; s2 += (v[j].x * v[j].x + v[j].y * v[j].y) + (v[j].z * v[j].z + v[j].w * v[j].w); }
        const float rstd = 1.f / sqrtf(wave_sum(s2) * (1.f / DM) + LN_EPS);
        f32x4* of = (f32x4*)(h1f + (size_t)m * DM) + lane; unsigned long long* ob = (unsigned long long*)(h1b + (size_t)m * DM) + lane;
#pragma unroll
        for (int j = 0; j < 4; ++j) { const f32x4 o = v[j] * rstd * gg[j] + bb[j]; of[64 * j] = o; ob[64 * j] = (unsigned long long)pk2(o.x, o.y) | ((unsigned long long)pk2(o.z, o.w) << 32); }
    }
}

__device__ __forceinline__ int tokey(float f) { const int u = __builtin_bit_cast(int, f); return u ^ ((u >> 31) & 0x7fffffff); }
__device__ __forceinline__ float fromkey(int k) { const int u = k ^ ((k >> 31) & 0x7fffffff); return __builtin_bit_cast(float, u); }
#define CSWAP_DESC(a, b) do { const int _x = (a), _y = (b); (a) = _x > _y ? _x : _y; (b) = _x > _y ? _y : _x; } while (0)
__device__ __forceinline__ void sort16_desc(int (&v)[16]) {
#pragma unroll
    for (int k = 2; k <= 16; k <<= 1)
#pragma unroll
        for (int j = k >> 1; j > 0; j >>= 1)
#pragma unroll
            for (int i = 0; i < 16; ++i) { const int l = i ^ j; if (l > i) { if ((i & k) == 0) CSWAP_DESC(v[i], v[l]); else CSWAP_DESC(v[l], v[i]); } }
}
__device__ __forceinline__ void merge16(int (&a)[16], const int (&b)[16]) {
#pragma unroll
    for (int i = 0; i < 16; ++i) a[i] = a[i] > b[15 - i] ? a[i] : b[15 - i];
#pragma unroll
    for (int j = 8; j > 0; j >>= 1)
#pragma unroll
        for (int i = 0; i < 16; ++i) { const int l = i ^ j; if (l > i) CSWAP_DESC(a[i], a[l]); }
}
__device__ __forceinline__ void top16_of_64(const int (&k)[64], int (&out)[16]) {
    int g1[16], g2[16], g3[16];
#pragma unroll
    for (int i = 0; i < 16; ++i) { out[i] = k[i]; g1[i] = k[16 + i]; g2[i] = k[32 + i]; g3[i] = k[48 + i]; }
    sort16_desc(out); sort16_desc(g1); sort16_desc(g2); sort16_desc(g3);
    merge16(out, g1); merge16(g2, g3); merge16(out, g2);
}
struct CandTab { int ci[64]; int cj[64]; int n; };
constexpr CandTab make_cand() { CandTab t{}; int n = 0; for (int i = 0; i < 16; ++i) for (int j = 0; j < 16; ++j) if ((i + 1) * (j + 1) <= 16) { t.ci[n] = i; t.cj[n] = j; ++n; } t.n = n; return t; }
constexpr CandTab CT = make_cand();
static_assert(CT.n == 50, "staircase candidates");

constexpr int TK_SKP = 272;
constexpr int TK_SK2 = 128 * TK_SKP, TK_SCR = 2 * 128 * TK_SKP;

__device__ __forceinline__ void phase_topk(const Params& P, LAS unsigned char* lds, const bf16* qpeer) {
    const int tid = threadIdx.x, lane = tid & 63, wave = __builtin_amdgcn_readfirstlane(tid >> 6), r = lane & 31, h = lane >> 5;
    int* eidx = (int*)(P.ws + WS_EIDX); float* gate = (float*)(P.ws + WS_GATE);
    __syncthreads();
    for (int e = tid; e < 2 * 128 * 32; e += NTHREADS) {
        const int which = e >> 12, rem = e & 4095, row = rem >> 5, c4 = rem & 31;
        const f32x4 v = *(const f32x4*)((which ? P.sk2 : P.sk1) + row * 128 + c4 * 4);
        u32x2 w; w.x = pk2(v.x, v.y); w.y = pk2(v.z, v.w);
        *(LAS u32x2*)(lds + which * TK_SK2 + row * TK_SKP + c4 * 8) = w;
    }
    __syncthreads();
    LAS int* scr = (LAS int*)(lds + TK_SCR + wave * 8192);
    for (int task = blockIdx.x * NWAVES + wave; task < 2048; task += gridDim.x * NWAVES) {
        const int tb = task >> 2, hp = task & 3;
        int L[2][2][16];
#pragma unroll
        for (int hh = 0; hh < 2; ++hh)
#pragma unroll
            for (int half = 0; half < 2; ++half) {
                const int head = 2 * hp + hh;
                asm volatile("" ::: "memory"); __builtin_amdgcn_sched_barrier(0);
                const bf16* qp = qpeer + (size_t)(32 * tb + r) * NPQ + 256 * head + 128 * half + 8 * h;
                bf16x8 qf[8];
#pragma unroll
                for (int s = 0; s < 8; ++s) qf[s] = *(const bf16x8*)(qp + 16 * s);
#pragma unroll
                for (int kt = 0; kt < 4; ++kt) {
                    __builtin_amdgcn_sched_barrier(0);
                    f32x16 acc;
#pragma unroll
                    for (int i = 0; i < 16; ++i) acc[i] = 0.f;
                    const LAS unsigned char* kp = lds + half * TK_SK2 + (kt * 32 + r) * TK_SKP + 16 * h;
#pragma unroll
                    for (int s = 0; s < 8; ++s) { const bf16x8 a = *(const LAS bf16x8*)(kp + 32 * s); acc = __builtin_amdgcn_mfma_f32_32x32x16_bf16(a, qf[s], acc, 0, 0, 0); }
                    int tk[16];
#pragma unroll
                    for (int i = 0; i < 16; ++i) { const int idx = kt * 32 + (i & 3) + 8 * (i >> 2) + 4 * h; tk[i] = (tokey(acc[i]) & ~127) | idx; }
                    sort16_desc(tk);
                    if (kt == 0) {
#pragma unroll
                        for (int i = 0; i < 16; ++i) L[hh][half][i] = tk[i];
                    } else merge16(L[hh][half], tk);
                }
            }
        int a[16], b[16];
#pragma unroll
        for (int half = 0; half < 2; ++half) {
            int own[16], oth[16];
#pragma unroll
            for (int i = 0; i < 16; ++i) {
                const int send = h ? L[0][half][i] : L[1][half][i];
                own[i] = h ? L[1][half][i] : L[0][half][i];
                oth[i] = __shfl_xor(send, 32);
            }
            merge16(own, oth);
#pragma unroll
            for (int i = 0; i < 16; ++i) { if (half == 0) a[i] = own[i]; else b[i] = own[i]; }
        }
        float fa[16], fb[16];
#pragma unroll
        for (int i = 0; i < 16; ++i) { fa[i] = fromkey(a[i] & ~127); fb[i] = fromkey(b[i] & ~127); scr[i * 64 + lane] = a[i] & 127; scr[(16 + i) * 64 + lane] = b[i] & 127; }
        int top[16];
#pragma unroll
        for (int gq = 0; gq < 4; ++gq) {
            __builtin_amdgcn_sched_barrier(0);
            int ck[16];
#pragma unroll
            for (int s2 = 0; s2 < 16; ++s2) {
                const int s = gq * 16 + s2;
                if (s < CT.n) ck[s2] = (tokey(fa[CT.ci[s]] + fb[CT.cj[s]]) & ~255) | (CT.ci[s] << 4) | CT.cj[s];
                else ck[s2] = (int)0x80000000;
            }
            sort16_desc(ck);
            if (gq == 0) {
#pragma unroll
                for (int i = 0; i < 16; ++i) top[i] = ck[i];
            } else merge16(top, ck);
        }
        float sc[16]; float ssum = 0.f;
        const float m0 = fromkey(top[0] & ~255);
#pragma unroll
        for (int i = 0; i < 16; ++i) { sc[i] = exp2f((fromkey(top[i] & ~255) - m0) * LOG2E); ssum += sc[i]; }
        const float rs = 1.f / ssum;
        const int head = 2 * hp + h;
        int* eo = eidx + ((size_t)(32 * tb + r) * 8 + head) * 16; float* go = gate + ((size_t)(32 * tb + r) * 8 + head) * 16;
#pragma unroll
        for (int q = 0; q < 4; ++q) {
            u32x4 ev; f32x4 gv;
#pragma unroll
            for (int e = 0; e < 4; ++e) {
                const int code = top[4 * q + e] & 255;
                const int i1 = scr[(code >> 4) * 64 + lane], i2 = scr[(16 + (code & 15)) * 64 + lane];
                ev[e] = (unsigned)(i1 * 128 + i2); gv[e] = sc[4 * q + e] * rs;
            }
            *(u32x4*)(eo + 4 * q) = ev; *(f32x4*)(go + 4 * q) = gv;
        }
    }
}

__device__ __forceinline__ float gelu_as(float v) {
    const float av = __builtin_fabsf(v), t = __builtin_amdgcn_rcpf(av * 0.2316418882f + 1.0f);
    float q = t * 0.5307027145f + (-0.7265760135f); q = q * t + 0.7107068705f; q = q * t + (-0.142248368f); q = q * t + 0.127414796f; q = q * t;
    const float e = __builtin_amdgcn_exp2f((v * v) * (-0.72134752044f));
    const float m = v * (q * e), r = v - m;
    return v < 0.f ? m : r;
}
#ifndef EX_PACE_TICKS
#define EX_PACE_TICKS 0
#endif
#define EX_CVT(w, hi) __builtin_amdgcn_cvt_pk_f32_fp8((int)(w), hi)
#define EX_DOT(uw, H, out) do { f32x2 s_ = EX_CVT((uw).x, false) * (H)[0], s2_ = EX_CVT((uw).x, true) * (H)[1]; \
    s_ = __builtin_elementwise_fma(EX_CVT((uw).y, false), (H)[2], s_); s2_ = __builtin_elementwise_fma(EX_CVT((uw).y, true), (H)[3], s2_); \
    s_ = __builtin_elementwise_fma(EX_CVT((uw).z, false), (H)[4], s_); s2_ = __builtin_elementwise_fma(EX_CVT((uw).z, true), (H)[5], s2_); \
    s_ = __builtin_elementwise_fma(EX_CVT((uw).w, false), (H)[6], s_); s2_ = __builtin_elementwise_fma(EX_CVT((uw).w, true), (H)[7], s2_); s_ = s_ + s2_; (out) = s_.x + s_.y; } while (0)
#define EX_ACC(vw, A, wv) do { const f32x2 w2_ = {(wv), (wv)}; \
    (A)[0] = __builtin_elementwise_fma(EX_CVT((vw).x, false), w2_, (A)[0]); (A)[1] = __builtin_elementwise_fma(EX_CVT((vw).x, true), w2_, (A)[1]); \
    (A)[2] = __builtin_elementwise_fma(EX_CVT((vw).y, false), w2_, (A)[2]); (A)[3] = __builtin_elementwise_fma(EX_CVT((vw).y, true), w2_, (A)[3]); \
    (A)[4] = __builtin_elementwise_fma(EX_CVT((vw).z, false), w2_, (A)[4]); (A)[5] = __builtin_elementwise_fma(EX_CVT((vw).z, true), w2_, (A)[5]); \
    (A)[6] = __builtin_elementwise_fma(EX_CVT((vw).w, false), w2_, (A)[6]); (A)[7] = __builtin_elementwise_fma(EX_CVT((vw).w, true), w2_, (A)[7]); } while (0)
__device__ __forceinline__ float dpp_f(float x, const int ctrl_unused) { return x; }
#define EX_DPP(x, ctrl) __uint_as_float((unsigned)__builtin_amdgcn_update_dpp(0, (int)__float_as_uint(x), (ctrl), 0xF, 0xF, true))
#define EX_LOADG(U_, V_, E_, G_, k0) do { unsigned off_[4]; _Pragma("unroll") for (int j_ = 0; j_ < 4; ++j_) { int k_ = (k0) + j_; k_ = k_ < 127 ? k_ : 127; \
    const int en_ = __builtin_amdgcn_readlane((k_ & 64) ? sex1 : sex0, k_ & 63), gn_ = __builtin_amdgcn_readlane((k_ & 64) ? sey1 : sey0, k_ & 63); \
    (E_)[j_] = (unsigned)en_; (G_)[j_] = __uint_as_float((unsigned)gn_); \
    off_[j_] = ((unsigned)en_ & 16383u) * 1024u + lane16; } \
    __builtin_amdgcn_sched_barrier(0); \
    _Pragma("unroll") for (int j_ = 0; j_ < 4; ++j_) (U_)[j_] = *(const u32x4*)(ub8 + off_[j_]); \
    _Pragma("unroll") for (int j_ = 0; j_ < 4; ++j_) (V_)[j_] = *(const u32x4*)(vb8 + off_[j_]); } while (0)
#define EX_COMPUTE(U_, V_, E_, G_) do { float d_[4]; \
    _Pragma("unroll") for (int j_ = 0; j_ < 4; ++j_) EX_DOT((U_)[j_], hf, d_[j_]); \
      \
    { const bool b0_ = lane & 1, b1_ = lane & 2; \
      float ka_ = b0_ ? d_[2] : d_[0], sa_ = b0_ ? d_[0] : d_[2], kb_ = b0_ ? d_[3] : d_[1], sb_ = b0_ ? d_[1] : d_[3]; \
      ka_ += EX_DPP(sa_, 0xB1); kb_ += EX_DPP(sb_, 0xB1); \
      float kc_ = b1_ ? kb_ : ka_, sc_ = b1_ ? ka_ : kb_; kc_ += EX_DPP(sc_, 0x4E); \
      kc_ += EX_DPP(kc_, 0x124); kc_ += EX_DPP(kc_, 0x128); \
      kc_ += __uint_as_float((unsigned)__builtin_amdgcn_ds_swizzle((int)__float_as_uint(kc_), 0x401F)); \
      { const auto rr_ = __builtin_amdgcn_permlane32_swap(__float_as_uint(kc_), __float_as_uint(kc_), false, false); kc_ = __uint_as_float(rr_[0]) + __uint_as_float(rr_[1]); } \
      const unsigned el_ = b0_ ? (b1_ ? (E_)[3] : (E_)[2]) : (b1_ ? (E_)[1] : (E_)[0]); const float gs_ = b0_ ? (b1_ ? (G_)[3] : (G_)[2]) : (b1_ ? (G_)[1] : (G_)[0]); \
      const float wl_ = gs_ * gelu_as(kc_ * __uint_as_float((el_ >> 16) << 23)); const int wi_ = (int)__float_as_uint(wl_); \
      d_[0] = __uint_as_float((unsigned)__builtin_amdgcn_readlane(wi_, 0)); d_[1] = __uint_as_float((unsigned)__builtin_amdgcn_readlane(wi_, 2)); \
      d_[2] = __uint_as_float((unsigned)__builtin_amdgcn_readlane(wi_, 1)); d_[3] = __uint_as_float((unsigned)__builtin_amdgcn_readlane(wi_, 3)); } \
    _Pragma("unroll") for (int j_ = 0; j_ < 4; ++j_) EX_ACC((V_)[j_], acc, d_[j_]); } while (0)

__device__ __forceinline__ void phase_expert(const Params& P, LAS unsigned char* lds) {
    const int tid = threadIdx.x, lane = tid & 63, wave = __builtin_amdgcn_readfirstlane(tid >> 6);
    const unsigned char* ub8 = P.ws + WS_UB8; const unsigned char* vb8 = P.ws + WS_VB8;
    const float* isu = (const float*)(P.ws + WS_ISU); const float* isv = (const float*)(P.ws + WS_ISV);
    const float* h1f = (const float*)(P.ws + WS_H1F);
    const int* eidx = (const int*)(P.ws + WS_EIDX); const float* gate = (const float*)(P.ws + WS_GATE);
    volatile LAS unsigned* hist = (volatile LAS unsigned*)(lds + wave * 2048);
    LAS u32x2* plist = (LAS u32x2*)(lds + wave * 2048 + 256);
    const unsigned lane16 = 16u * (unsigned)lane;
    __syncthreads();
#if EX_PACE_TICKS > 0
    const unsigned long long t_phase = __builtin_amdgcn_s_memrealtime() + 200;
#endif
#pragma unroll 1
    for (int tj = 0; tj < 8; ++tj) {
        const int t = 64 * (int)blockIdx.x + 8 * wave + tj;
        f32x2 hf[8], acc[8];
        { const f32x4* hp = (const f32x4*)(h1f + (size_t)t * DM + 16 * lane);
#pragma unroll
          for (int q = 0; q < 4; ++q) { const f32x4 v = hp[q]; hf[2 * q] = (f32x2){v.x, v.y}; hf[2 * q + 1] = (f32x2){v.z, v.w}; acc[2 * q] = (f32x2){0.f, 0.f}; acc[2 * q + 1] = (f32x2){0.f, 0.f}; } }
        hist[lane] = 0u;
        unsigned ev[2], rk[2]; float gs[2]; int basev;
#pragma unroll
        for (int q = 0; q < 2; ++q) {
            const unsigned e = (unsigned)eidx[(size_t)t * 128 + lane + 64 * q];
            ev[q] = e | ((__float_as_uint(isu[e]) >> 23) << 16); gs[q] = gate[(size_t)t * 128 + lane + 64 * q] * isv[e];
        }
#pragma unroll
        for (int q = 0; q < 2; ++q) {
            const unsigned b = (ev[q] & 16383u) >> 8;
            unsigned long long m = ~0ull;
#pragma unroll
            for (int bit = 0; bit < 6; ++bit) { const bool on = (b >> bit) & 1u; const unsigned long long bal = __ballot(on); m &= on ? bal : ~bal; }
            const unsigned before = (unsigned)__popcll(m & ((1ull << lane) - 1ull)), cnt = (unsigned)__popcll(m);
            const unsigned old = hist[b];
            rk[q] = old + before;
            if (before == 0u) hist[b] = old + cnt;
        }
        { unsigned c = hist[lane], inc = c;
#pragma unroll
          for (int o = 1; o < 64; o <<= 1) { const unsigned n = __shfl_up(inc, o); if (lane >= o) inc += n; }
          hist[lane] = inc - c; basev = (int)(inc - c); }
#pragma unroll
        for (int q = 0; q < 2; ++q) {
            const unsigned b = (ev[q] & 16383u) >> 8;
            const unsigned pos = hist[b] + rk[q];
            u32x2 en; en.x = ev[q]; en.y = __float_as_uint(gs[q]);
            plist[pos] = en;
        }
        const u32x2 s0 = plist[lane], s1 = plist[lane + 64];
        const int sex0 = (int)s0.x, sey0 = (int)s0.y, sex1 = (int)s1.x, sey1 = (int)s1.y;
        u32x4 Ua[4], Va[4], Ub[4], Vb[4]; unsigned Ea[4], Eb[4]; float Ga[4], Gb[4];
#if EX_PACE_TICKS > 0
        int kgrp = 0; const unsigned long long ts = t_phase + (unsigned long long)tj * (32 * EX_PACE_TICKS + 300);
#endif
        EX_LOADG(Ua, Va, Ea, Ga, 0);
#pragma unroll 1
        for (int k0 = 0; k0 < 128; k0 += 8) {
#if EX_PACE_TICKS > 0
            while (kgrp < 32 && k0 >= __builtin_amdgcn_readlane(basev, 2 * kgrp)) {
                const unsigned long long tgt = ts + (unsigned long long)kgrp * EX_PACE_TICKS;
                while (__builtin_amdgcn_s_memrealtime() < tgt) __builtin_amdgcn_s_sleep(2);
                ++kgrp;
            }
#endif
            EX_LOADG(Ub, Vb, Eb, Gb, k0 + 4); __builtin_amdgcn_sched_barrier(0);
            EX_COMPUTE(Ua, Va, Ea, Ga); __builtin_amdgcn_sched_barrier(0);
            EX_LOADG(Ua, Va, Ea, Ga, k0 + 8); __builtin_amdgcn_sched_barrier(0);
            EX_COMPUTE(Ub, Vb, Eb, Gb); __builtin_amdgcn_sched_barrier(0);
        }
        (void)basev;
        {
            f32x2 v[8]; float s = 0.f;
#pragma unroll
            for (int q = 0; q < 8; ++q) { v[q] = hf[q] * DN_ALPHA + acc[q]; s += v[q].x + v[q].y; }
            const float mean = wave_sum(s) * (1.f / DM); float s2 = 0.f;
#pragma unroll
            for (int q = 0; q < 8; ++q) { v[q] = v[q] - mean; s2 += v[q].x * v[q].x + v[q].y * v[q].y; }
            const float rstd = 1.f / sqrtf(wave_sum(s2) * (1.f / DM) + LN_EPS);
            float* orow = P.out + (size_t)t * DM + 16 * lane;
#pragma unroll
            for (int q = 0; q < 4; ++q) {
                const f32x4 gg = *(const f32x4*)(P.ln2g + 16 * lane + 4 * q), bb = *(const f32x4*)(P.ln2b + 16 * lane + 4 * q);
                f32x4 o; o.x = v[2 * q].x * rstd * gg.x + bb.x; o.y = v[2 * q].y * rstd * gg.y + bb.y; o.z = v[2 * q + 1].x * rstd * gg.z + bb.z; o.w = v[2 * q + 1].y * rstd * gg.w + bb.w;
                *(f32x4*)(orow + 4 * q) = o;
            }
        }
    }
}

#define XB_TMO      128
#define XB_XCNT(j)  (256  + 64 * (j))
#define XB_XSUB(j)  (1280 + 64 * (j))
#define XB_XGEN(j)  (2304 + 64 * (j))
#define XB_TOP      3328
#define XB_TOPGEN   3392
#define XCD_BAR_WORDS 3456
#define XB_SPIN_CAP (1u << 18)

__device__ __forceinline__ unsigned xb_ld(unsigned* p)              { return __hip_atomic_load(p, __ATOMIC_RELAXED, __HIP_MEMORY_SCOPE_AGENT); }
__device__ __forceinline__ unsigned xb_add(unsigned* p, unsigned v) { return __hip_atomic_fetch_add(p, v, __ATOMIC_RELAXED, __HIP_MEMORY_SCOPE_AGENT); }
__device__ __forceinline__ unsigned xb_xcc_id() { return (unsigned)__builtin_amdgcn_s_getreg((3 << 11) | 20) & 0xFu; }
#define XB_SPIN(cond, bar) do { unsigned _sp = 0; while (cond) { __builtin_amdgcn_s_sleep(1); \
    if ((++_sp & 255u) == 0u) { if (xb_ld(&(bar)[XB_TMO])) break; if (_sp > XB_SPIN_CAP) { atomicAdd(&(bar)[XB_TMO], 1u); break; } } } } while (0)

struct XcdBarrier {
    unsigned* bar; unsigned x;
    volatile LAS unsigned* st;
};

__device__ __forceinline__ XcdBarrier xcd_barrier_post(unsigned* bar, volatile LAS unsigned* st) {
    XcdBarrier b; b.bar = bar; b.x = xb_xcc_id(); b.st = st;
    if (threadIdx.x == 0) (void)xb_add(&bar[XB_XCNT(b.x)], 1u);
    return b;
}
__device__ __forceinline__ void xcd_barrier_complete(unsigned* bar, unsigned x, unsigned& nloc, unsigned& nx) {
    const unsigned G = gridDim.x * gridDim.y * gridDim.z;
    unsigned sum, cnt, mine, sp = 0u;
    for (;;) {
        sum = 0u; cnt = 0u; mine = 0u;
#pragma unroll
        for (unsigned j = 0; j < 16; ++j) { const unsigned c = xb_ld(&bar[XB_XCNT(j)]); sum += c; cnt += (c > 0u) ? 1u : 0u; mine = (j == x) ? c : mine; }
        if (sum == G) break;
        __builtin_amdgcn_s_sleep(1);
        if ((++sp & 255u) == 0u) { if (xb_ld(&bar[XB_TMO])) break; if (sp > XB_SPIN_CAP) { atomicAdd(&bar[XB_TMO], 1u); break; } }
    }
    nloc = mine > 0u ? mine : 1u; nx = cnt > 0u ? cnt : 1u;
}

__device__ __forceinline__ void xcd_barrier(const XcdBarrier& b) {
    asm volatile("s_waitcnt vmcnt(0)" ::: "memory");
    __syncthreads();
    if (threadIdx.x == 0) {
        unsigned* bar = b.bar;
        __builtin_amdgcn_s_waitcnt(0);
        unsigned nloc = b.st[0], nx = b.st[1];
        if (nloc == 0u) { xcd_barrier_complete(bar, b.x, nloc, nx); b.st[0] = nloc; b.st[1] = nx; }
        const unsigned old = xb_add(&bar[XB_XSUB(b.x)], 1u);
        const unsigned gen = old / nloc;
        if (old + 1u == (gen + 1u) * nloc) {
            __builtin_amdgcn_fence(__ATOMIC_RELEASE, "agent");
            asm volatile("s_waitcnt vmcnt(0)" ::: "memory");
            const unsigned og = xb_add(&bar[XB_TOP], 1u);
            const unsigned tg = og / nx;
            if (og + 1u == (tg + 1u) * nx) xb_add(&bar[XB_TOPGEN], 1u);
            else XB_SPIN(xb_ld(&bar[XB_TOPGEN]) == tg, bar);
            __builtin_amdgcn_fence(__ATOMIC_ACQUIRE, "agent");
            xb_add(&bar[XB_XGEN(b.x)], 1u);
            asm volatile("s_waitcnt vmcnt(0)" ::: "memory");
        } else {
            XB_SPIN(xb_ld(&bar[XB_XGEN(b.x)]) == gen, bar);
            __builtin_amdgcn_fence(__ATOMIC_ACQUIRE, "agent");
            asm volatile("s_waitcnt vmcnt(0)" ::: "memory");
        }
    }
    __syncthreads();
}

constexpr int MISC_OFF = LDS_BYTES - 256;
constexpr int CW_BAR = 4096;
constexpr size_t CTL_ZERO_BYTES = 65536;

__global__ void __launch_bounds__(NTHREADS, 2) fwd_megakernel(Params P) {
    extern __shared__ __attribute__((aligned(16))) unsigned char lds_raw[];
    LAS unsigned char* lds = (LAS unsigned char*)lds_raw;
    const int tid = threadIdx.x;
    volatile LAS unsigned* MISC = (volatile LAS unsigned*)(lds + MISC_OFF);
    if (tid < 64) MISC[tid] = 0u;
    __syncthreads();
    XcdBarrier bar = xcd_barrier_post((unsigned*)(P.ws + WS_CTL) + CW_BAR, MISC + 8);

    phase_prologue(P, lds);
    xcd_barrier(bar);
    { pg8::Gemm g{(const bf16*)(P.ws + WS_XB), (const bf16*)(P.ws + WS_WIN), NTOK, NPROJ, DM}; pg8::StaticOrder S; S.init(NTOK, NPROJ, gridDim.x, (int)blockIdx.x);
      pg8::EpiProj E{(bf16*)(P.ws + WS_PROJ), P.b_in, (const float*)(P.ws + WS_CS)};
      pg8::gemm_phase<pg8::EpiProj, pg8::StaticOrder, true, true>(lds, g, S, E); }
    xcd_barrier(bar);
    phase_attn(P, lds);
    xcd_barrier(bar);
    { pg8::Gemm g{(const bf16*)(P.ws + WS_Y), (const bf16*)(P.ws + WS_WOUT), NTOK, DM, DM}; pg8::StaticOrder S; S.init(NTOK, DM, gridDim.x, (int)blockIdx.x);
      pg8::EpiF32 E{P.out, DM, P.b_out};
      pg8::gemm_phase<pg8::EpiF32, pg8::StaticOrder, true, true>(lds, g, S, E); }
    xcd_barrier(bar);
    phase_ln1(P, P.out);
    xcd_barrier(bar);
    { pg8::Gemm g{(const bf16*)(P.ws + WS_H1B), (const bf16*)(P.ws + WS_WPQ), NTOK, NPQ, DM}; pg8::StaticOrder S; S.init(NTOK, NPQ, gridDim.x, (int)blockIdx.x);
      pg8::EpiBf16<0> E{(bf16*)P.out, NPQ, nullptr, 0, 0, 1.f};
      pg8::gemm_phase<pg8::EpiBf16<0>, pg8::StaticOrder, true, true>(lds, g, S, E); }
    xcd_barrier(bar);
    phase_topk(P, lds, (const bf16*)P.out);
    xcd_barrier(bar);
    phase_expert(P, lds);
}

extern "C" void kernel_launch(void* const* d_in, const int* in_sizes, int n_in, void* d_out, int out_size, void* d_ws, size_t ws_size, hipStream_t stream) {
    static int grid = 0;
    if (grid == 0) {
        if (n_in != 17 || out_size != NTOK * DM || ws_size < WS_END) { fprintf(stderr, "kernel_launch: unexpected shapes (n_in %d out %d ws %zu)\n", n_in, out_size, ws_size); grid = -1; return; }
        int dev = 0, cus = 0, per_cu = 0;
        if (hipGetDevice(&dev) != hipSuccess || hipDeviceGetAttribute(&cus, hipDeviceAttributeMultiprocessorCount, dev) != hipSuccess) { grid = -1; return; }
        if (hipFuncSetAttribute((const void*)fwd_megakernel, hipFuncAttributeMaxDynamicSharedMemorySize, LDS_BYTES) != hipSuccess) { fprintf(stderr, "kernel_launch: hipFuncSetAttribute failed\n"); grid = -1; return; }
        if (hipOccupancyMaxActiveBlocksPerMultiprocessor(&per_cu, (const void*)fwd_megakernel, NTHREADS, LDS_BYTES) != hipSuccess || per_cu < 1) { fprintf(stderr, "kernel_launch: occupancy query says %d blocks per CU\n", per_cu); (void)hipGetLastError(); grid = -1; return; }
        grid = cus;
        if (grid != 256) { fprintf(stderr, "kernel_launch: this kernel is built for a 256-CU device (got %d)\n", cus); grid = -1; return; }
    }
    if (grid < 0) return;
    if (hipMemsetAsync((char*)d_ws + WS_CTL, 0, CTL_ZERO_BYTES, stream) != hipSuccess) return;
    Params P{};
    P.x = (const float*)d_in[0]; P.pos = (const int*)d_in[1]; P.w_in = (const float*)d_in[2]; P.b_in = (const float*)d_in[3]; P.sinks = (const float*)d_in[4];
    P.conv_w = (const float*)d_in[5]; P.w_out = (const float*)d_in[6]; P.b_out = (const float*)d_in[7]; P.ln1g = (const float*)d_in[8]; P.ln1b = (const float*)d_in[9];
    P.w_pq = (const float*)d_in[10]; P.sk1 = (const float*)d_in[11]; P.sk2 = (const float*)d_in[12]; P.ue = (const float*)d_in[13]; P.ve = (const float*)d_in[14];
    P.ln2g = (const float*)d_in[15]; P.ln2b = (const float*)d_in[16]; P.out = (float*)d_out; P.ws = (unsigned char*)d_ws;
    hipLaunchKernelGGL(fwd_megakernel, dim3(grid), dim3(NTHREADS), LDS_BYTES, stream, P);
}
```
